# Optimizing an MI355X kernel written in HIP

```python
import math
import jax, jax.numpy as jnp
from jax import lax
import numpy as np

D_MODEL = 1024
BATCH = 2
SEQ = 8192
DEPTH = 2

PLE_DIM = 256
ROPE_THETA = 10000.0
EPS = 1e-6
NEG_INF = -1e30
HEAD_DIM = 64

A_HEADS = 8
A_KV_GROUPS = 2
A_CMP_LEN = 32
A_CMP_STRIDE = 16
A_CMP_HIDDEN = 256
A_SEL_LEN = 64
A_TOPK = 16
A_WINDOW = 512
A_Q_CHUNK = 128
A_FORCE_BONUS = 1e4

B_HEADS = 8
B_KV_HEADS = 2
B_WINDOW = 128
B_BLOCK = 128

C_HEADS = 8
C_Q_RANK = 256
C_KV_RANK = 256
C_NOPE = 64
C_ROPE = 32
C_V = 64
C_Q_BLOCK = 128

D_FF = int(math.ceil(8 * D_MODEL / 3 / 256)) * 256

A_Q = A_HEADS * HEAD_DIM
A_KV = A_KV_GROUPS * HEAD_DIM
A_GATES = A_HEADS * 3
B_Q = B_HEADS * HEAD_DIM
B_KV = B_KV_HEADS * HEAD_DIM
IN_SIZES = (A_Q, A_KV, A_KV, A_KV, A_KV, A_KV, A_KV, A_GATES, B_Q, B_KV, B_KV, C_Q_RANK, C_KV_RANK, C_ROPE)
IN_COLS = sum(IN_SIZES)
A_OUT = A_HEADS * HEAD_DIM
B_OUT = B_HEADS * HEAD_DIM
C_OUT = C_HEADS * C_V

kernel_name = "hybrid_nsa_swa_sink_mla_gated_block"


def rmsnorm(x, g):
    xf = x.astype(jnp.float32)
    y = xf * lax.rsqrt(jnp.mean(xf * xf, axis=-1, keepdims=True) + EPS)
    return (y * g.astype(jnp.float32)).astype(x.dtype)


def rope_tables(positions, dim):
    inv_freq = jnp.power(jnp.float32(ROPE_THETA), -jnp.arange(0, dim, 2, dtype=jnp.float32) / dim)
    ang = positions.astype(jnp.float32)[..., None] * inv_freq
    return jnp.cos(ang), jnp.sin(ang)


def apply_rope(x, cos, sin):
    half = x.shape[-1] // 2
    xf = x.astype(jnp.float32)
    x1, x2 = xf[..., :half], xf[..., half:]
    c, s = cos[:, :, None, :], sin[:, :, None, :]
    return jnp.concatenate([x1 * c - x2 * s, x2 * c + x1 * s], axis=-1).astype(x.dtype)


def masked_softmax(scores, mask):
    p = jax.nn.softmax(jnp.where(mask, scores, NEG_INF), axis=-1)
    return jnp.where(mask, p, 0.0)


def compress_blocks(t, tok, pos, w1, w2):
    B, _, G, dh = t.shape
    n_cmp, L = tok.shape
    blocks = t[:, tok] + pos[:, None, :].astype(t.dtype)
    flat = blocks.transpose(0, 1, 3, 2, 4).reshape(B, n_cmp, G, L * dh)
    return jax.nn.gelu(flat @ w1) @ w2


def nsa_attention(q, kc, vc, ks, vs, kw, vw, gate_logits, pos_k, w1_k, w2_k, pos_v, w1_v, w2_v):
    B, S = q.shape[0], q.shape[1]
    G, R, dh = A_KV_GROUPS, A_HEADS // A_KV_GROUPS, HEAD_DIM
    QC = A_Q_CHUNK
    scale = dh ** -0.5
    dt = q.dtype
    qg = q.reshape(B, S, G, R, dh)
    gates = jax.nn.sigmoid(gate_logits.astype(jnp.float32)).reshape(B, S, G, R, 3).astype(dt)
    n_cmp = (S - A_CMP_LEN) // A_CMP_STRIDE + 1
    tok = np.arange(n_cmp)[:, None] * A_CMP_STRIDE + np.arange(A_CMP_LEN)[None, :]
    k_cmp = compress_blocks(kc, tok, pos_k, w1_k, w2_k)
    v_cmp = compress_blocks(vc, tok, pos_v, w1_v, w2_v)
    cmp_end = jnp.asarray(tok[:, -1], jnp.int32)
    n_sel = S // A_SEL_LEN
    sel_map = np.zeros((n_cmp, n_sel), np.float32)
    np.add.at(sel_map, (np.repeat(np.arange(n_cmp), A_CMP_LEN), (tok // A_SEL_LEN).reshape(-1)), 1.0 / A_CMP_LEN)
    sel_map = jnp.asarray(sel_map)
    top_k = min(A_TOPK, n_sel)
    ks_blk = ks.transpose(0, 2, 1, 3).reshape(B, G, n_sel, A_SEL_LEN * dh)
    vs_blk = vs.transpose(0, 2, 1, 3).reshape(B, G, n_sel, A_SEL_LEN * dh)
    gather_blocks = jax.vmap(jax.vmap(lambda t, i: t[i]))
    kw_pad = jnp.pad(kw, ((0, 0), (A_WINDOW, 0), (0, 0), (0, 0)))
    vw_pad = jnp.pad(vw, ((0, 0), (A_WINDOW, 0), (0, 0), (0, 0)))
    blk_ids = jnp.arange(n_sel)

    def chunk(c):
        t0 = c * QC
        tq = t0 + jnp.arange(QC)
        qc = lax.dynamic_slice_in_dim(qg, t0, QC, axis=1)
        gc = lax.dynamic_slice_in_dim(gates, t0, QC, axis=1)
        s = jnp.einsum('bqgrd,bngd->bgrqn', qc, k_cmp).astype(jnp.float32) * scale
        p_cmp = masked_softmax(s, cmp_end[None, :] <= tq[:, None])
        o_cmp = jnp.einsum('bgrqn,bngd->bqgrd', p_cmp.astype(dt), v_cmp)
        imp = jnp.einsum('bgrqn,nj->bgqj', p_cmp, sel_map)
        cur = tq // A_SEL_LEN
        valid = blk_ids[None, :] <= cur[:, None]
        forced = (blk_ids[None, :] == 0) | (blk_ids[None, :] == cur[:, None]) | (blk_ids[None, :] == cur[:, None] - 1)
        imp = jnp.where(valid, imp + jnp.where(forced, A_FORCE_BONUS, 0.0), NEG_INF)
        _, top_idx = lax.top_k(imp, top_k)
        idx_flat = top_idx.reshape(B, G, QC * top_k)
        kb = gather_blocks(ks_blk, idx_flat).reshape(B, G, QC, top_k * A_SEL_LEN, dh)
        vb = gather_blocks(vs_blk, idx_flat).reshape(B, G, QC, top_k * A_SEL_LEN, dh)
        key_pos = (top_idx[..., None] * A_SEL_LEN + jnp.arange(A_SEL_LEN)).reshape(B, G, QC, top_k * A_SEL_LEN)
        m_sel = key_pos <= tq[None, None, :, None]
        s = jnp.einsum('bqgrd,bgqkd->bgrqk', qc, kb).astype(jnp.float32) * scale
        p_sel = masked_softmax(s, m_sel[:, :, None])
        o_sel = jnp.einsum('bgrqk,bgqkd->bqgrd', p_sel.astype(dt), vb)
        kwc = lax.dynamic_slice_in_dim(kw_pad, t0, QC + A_WINDOW, axis=1)
        vwc = lax.dynamic_slice_in_dim(vw_pad, t0, QC + A_WINDOW, axis=1)
        kp = t0 - A_WINDOW + jnp.arange(QC + A_WINDOW)
        m_win = (kp[None, :] <= tq[:, None]) & (kp[None, :] > tq[:, None] - A_WINDOW) & (kp[None, :] >= 0)
        s = jnp.einsum('bqgrd,bkgd->bgrqk', qc, kwc).astype(jnp.float32) * scale
        p_win = masked_softmax(s, m_win)
        o_win = jnp.einsum('bgrqk,bkgd->bqgrd', p_win.astype(dt), vwc)
        return gc[..., 0:1] * o_cmp + gc[..., 1:2] * o_sel + gc[..., 2:3] * o_win

    out = lax.map(chunk, jnp.arange(S // QC))
    return out.transpose(1, 0, 2, 3, 4, 5).reshape(B, S, A_HEADS * dh)


def swa_sink_attention(q, k, v, sinks):
    B, S = q.shape[0], q.shape[1]
    G, R, dh, BLK = B_KV_HEADS, B_HEADS // B_KV_HEADS, HEAD_DIM, B_BLOCK
    nb = S // BLK
    qb = q.reshape(B, nb, BLK, G, R, dh)

    def band(t):
        tb = t.reshape(B, nb, BLK, G, dh)
        prev = jnp.pad(tb, ((0, 0), (1, 0), (0, 0), (0, 0), (0, 0)))[:, :-1]
        return jnp.concatenate([prev, tb], axis=2)

    kb, vb = band(k), band(v)
    s = jnp.einsum('bnqgrd,bnkgd->bngrqk', qb, kb).astype(jnp.float32) * (dh ** -0.5)
    qi = jnp.arange(BLK)[:, None]
    kj = jnp.arange(2 * BLK)[None, :] - BLK
    rel = (kj <= qi) & (kj > qi - B_WINDOW)
    mask = rel[None] & ((jnp.arange(nb)[:, None, None] > 0) | (kj[None] >= 0))
    s = jnp.where(mask[None, :, None, None], s, NEG_INF)
    sink = jnp.broadcast_to(sinks.astype(jnp.float32).reshape(G, R)[None, None, :, :, None, None], s.shape[:-1] + (1,))
    p = jax.nn.softmax(jnp.concatenate([s, sink], axis=-1), axis=-1)[..., :-1]
    o = jnp.einsum('bngrqk,bnkgd->bnqgrd', p.astype(v.dtype), vb)
    return o.reshape(B, S, B_HEADS * dh)


def causal_block_attention(q, k, v, scale):
    B, S, H, _ = q.shape
    dv = v.shape[-1]
    key_pos = jnp.arange(S)

    def body(c):
        t0 = c * C_Q_BLOCK
        qb = lax.dynamic_slice_in_dim(q, t0, C_Q_BLOCK, axis=1)
        s = jnp.einsum('bqhd,bkhd->bhqk', qb, k).astype(jnp.float32) * scale
        mask = key_pos[None, :] <= (t0 + jnp.arange(C_Q_BLOCK))[:, None]
        p = jax.nn.softmax(jnp.where(mask, s, NEG_INF), axis=-1)
        return jnp.einsum('bhqk,bkhd->bqhd', p.astype(v.dtype), v)

    out = lax.map(body, jnp.arange(S // C_Q_BLOCK))
    return out.transpose(1, 0, 2, 3, 4).reshape(B, S, H * dv)


def mla_attention(cq, ckv, k_pe_raw, q_norm, w_q_up, kv_norm, w_kv_up, cos32, sin32):
    B, S = cq.shape[0], cq.shape[1]
    q = (rmsnorm(cq, q_norm) @ w_q_up).reshape(B, S, C_HEADS, C_NOPE + C_ROPE)
    q_nope, q_pe = q[..., :C_NOPE], apply_rope(q[..., C_NOPE:], cos32, sin32)
    kv = (rmsnorm(ckv, kv_norm) @ w_kv_up).reshape(B, S, C_HEADS, C_NOPE + C_V)
    k_nope, v = kv[..., :C_NOPE], kv[..., C_NOPE:]
    k_pe = apply_rope(k_pe_raw[:, :, None, :], cos32, sin32)
    qf = jnp.concatenate([q_nope, q_pe], axis=-1)
    kf = jnp.concatenate([k_nope, jnp.broadcast_to(k_pe, (B, S, C_HEADS, C_ROPE))], axis=-1)
    return causal_block_attention(qf, kf, v, (C_NOPE + C_ROPE) ** -0.5)


def hybrid_layer(x, p_i, rope64, rope32, mix_norm, w_in, a_cmp_pos_k, a_cmp_w1_k, a_cmp_w2_k,
                 a_cmp_pos_v, a_cmp_w1_v, a_cmp_w2_v, b_sinks, c_q_norm, c_w_q_up, c_kv_norm, c_w_kv_up,
                 w_branch_gate, w_branch_a, w_branch_b, w_branch_c, w_out, ffn_norm, w_ffn_gate, w_ffn_up,
                 w_ffn_down, ple_norm, w_ple_proj, w_ple_gate):
    B, S, _ = x.shape
    cos64, sin64 = rope64
    cos32, sin32 = rope32
    h = rmsnorm(x, mix_norm)
    z = h @ w_in
    split_points = [int(v) for v in np.cumsum(IN_SIZES)[:-1]]
    (a_q, a_kc, a_vc, a_ks, a_vs, a_kw, a_vw, a_g, b_q, b_k, b_v, c_cq, c_ckv, c_kpe) = jnp.split(z, split_points, axis=-1)

    def heads(t, n):
        return t.reshape(B, S, n, -1)

    def rot(t, n):
        return apply_rope(heads(t, n), cos64, sin64)

    G = A_KV_GROUPS
    o_a = nsa_attention(rot(a_q, A_HEADS), rot(a_kc, G), heads(a_vc, G), rot(a_ks, G), heads(a_vs, G),
                        rot(a_kw, G), heads(a_vw, G), a_g, a_cmp_pos_k, a_cmp_w1_k, a_cmp_w2_k,
                        a_cmp_pos_v, a_cmp_w1_v, a_cmp_w2_v)
    o_b = swa_sink_attention(rot(b_q, B_HEADS), rot(b_k, B_KV_HEADS), heads(b_v, B_KV_HEADS), b_sinks)
    o_c = mla_attention(c_cq, c_ckv, c_kpe, c_q_norm, c_w_q_up, c_kv_norm, c_w_kv_up, cos32, sin32)

    g = jax.nn.sigmoid((h @ w_branch_gate).astype(jnp.float32)).astype(x.dtype)
    g_a, g_b, g_c = jnp.split(g, 3, axis=-1)
    merged = g_a * (o_a @ w_branch_a) + g_b * (o_b @ w_branch_b) + g_c * (o_c @ w_branch_c)
    x = x + merged @ w_out

    h2 = rmsnorm(x, ffn_norm)
    x = x + (jax.nn.silu(h2 @ w_ffn_gate) * (h2 @ w_ffn_up)) @ w_ffn_down

    gate = jax.nn.sigmoid((rmsnorm(x, ple_norm) @ w_ple_gate).astype(jnp.float32)).astype(x.dtype)
    return x + gate * (p_i.astype(x.dtype) @ w_ple_proj)


def setup_inputs(seed: int = 0) -> dict:
    key = jax.random.key(seed)
    ks = jax.random.split(key, 32)

    def dense(k, shape, fan_in):
        return jax.random.normal(k, shape, jnp.float32) * (fan_in ** -0.5)

    def gain(k, shape):
        return 1.0 + 0.05 * jax.random.normal(k, shape, jnp.float32)

    L, dh = A_CMP_LEN, HEAD_DIM
    return {
        "x": jax.random.normal(ks[0], (BATCH, SEQ, D_MODEL), jnp.float32),
        "p": jax.random.normal(ks[1], (DEPTH, BATCH, SEQ, PLE_DIM), jnp.float32),
        "positions": jnp.broadcast_to(jnp.arange(SEQ, dtype=jnp.int32)[None, :], (BATCH, SEQ)),
        "mix_norm": gain(ks[2], (DEPTH, D_MODEL)),
        "w_in": dense(ks[3], (DEPTH, D_MODEL, IN_COLS), D_MODEL),
        "a_cmp_pos_k": 0.2 * jax.random.normal(ks[4], (DEPTH, L, dh), jnp.float32),
        "a_cmp_w1_k": dense(ks[5], (DEPTH, L * dh, A_CMP_HIDDEN), L * dh),
        "a_cmp_w2_k": dense(ks[6], (DEPTH, A_CMP_HIDDEN, dh), A_CMP_HIDDEN),
        "a_cmp_pos_v": 0.2 * jax.random.normal(ks[7], (DEPTH, L, dh), jnp.float32),
        "a_cmp_w1_v": dense(ks[8], (DEPTH, L * dh, A_CMP_HIDDEN), L * dh),
        "a_cmp_w2_v": dense(ks[9], (DEPTH, A_CMP_HIDDEN, dh), A_CMP_HIDDEN),
        "b_sinks": 0.5 * jax.random.normal(ks[10], (DEPTH, B_HEADS), jnp.float32),
        "c_q_norm": gain(ks[11], (DEPTH, C_Q_RANK)),
        "c_w_q_up": dense(ks[12], (DEPTH, C_Q_RANK, C_HEADS * (C_NOPE + C_ROPE)), C_Q_RANK),
        "c_kv_norm": gain(ks[13], (DEPTH, C_KV_RANK)),
        "c_w_kv_up": dense(ks[14], (DEPTH, C_KV_RANK, C_HEADS * (C_NOPE + C_V)), C_KV_RANK),
        "w_branch_gate": dense(ks[15], (DEPTH, D_MODEL, 3 * D_MODEL), D_MODEL),
        "w_branch_a": dense(ks[16], (DEPTH, A_OUT, D_MODEL), A_OUT),
        "w_branch_b": dense(ks[17], (DEPTH, B_OUT, D_MODEL), B_OUT),
        "w_branch_c": dense(ks[18], (DEPTH, C_OUT, D_MODEL), C_OUT),
        "w_out": dense(ks[19], (DEPTH, D_MODEL, D_MODEL), D_MODEL),
        "ffn_norm": gain(ks[20], (DEPTH, D_MODEL)),
        "w_ffn_gate": dense(ks[21], (DEPTH, D_MODEL, D_FF), D_MODEL),
        "w_ffn_up": dense(ks[22], (DEPTH, D_MODEL, D_FF), D_MODEL),
        "w_ffn_down": dense(ks[23], (DEPTH, D_FF, D_MODEL), D_FF),
        "ple_norm": gain(ks[24], (DEPTH, D_MODEL)),
        "w_ple_proj": dense(ks[25], (DEPTH, PLE_DIM, D_MODEL), PLE_DIM),
        "w_ple_gate": dense(ks[26], (DEPTH, D_MODEL, D_MODEL), D_MODEL),
        "final_norm": gain(ks[27], (D_MODEL,)),
    }


def reference(x, p, positions, mix_norm, w_in, a_cmp_pos_k, a_cmp_w1_k, a_cmp_w2_k, a_cmp_pos_v,
              a_cmp_w1_v, a_cmp_w2_v, b_sinks, c_q_norm, c_w_q_up, c_kv_norm, c_w_kv_up, w_branch_gate,
              w_branch_a, w_branch_b, w_branch_c, w_out, ffn_norm, w_ffn_gate, w_ffn_up, w_ffn_down,
              ple_norm, w_ple_proj, w_ple_gate, final_norm):
    rope64 = rope_tables(positions, HEAD_DIM)
    rope32 = rope_tables(positions, C_ROPE)
    for i in range(DEPTH):
        x = hybrid_layer(x, p[i], rope64, rope32, mix_norm[i], w_in[i], a_cmp_pos_k[i], a_cmp_w1_k[i],
                         a_cmp_w2_k[i], a_cmp_pos_v[i], a_cmp_w1_v[i], a_cmp_w2_v[i], b_sinks[i],
                         c_q_norm[i], c_w_q_up[i], c_kv_norm[i], c_w_kv_up[i], w_branch_gate[i],
                         w_branch_a[i], w_branch_b[i], w_branch_c[i], w_out[i], ffn_norm[i],
                         w_ffn_gate[i], w_ffn_up[i], w_ffn_down[i], ple_norm[i], w_ple_proj[i],
                         w_ple_gate[i])
    return rmsnorm(x, final_norm)
```

```cpp
#include <hip/hip_runtime.h>
#include <hip/hip_cooperative_groups.h>
#include <stdint.h>
#include <stdio.h>
namespace cg = cooperative_groups;

typedef unsigned short bf16_t;
typedef __attribute__((ext_vector_type(8))) short bf16x8;
typedef __attribute__((ext_vector_type(4))) float f32x4;
typedef __attribute__((ext_vector_type(16))) float f32x16;
typedef __attribute__((ext_vector_type(4))) unsigned u32x4;
#define DI __device__ __forceinline__
#define GAS __attribute__((address_space(1)))
DI char* launder(char* p) {
  unsigned long long v = (unsigned long long)p;
  asm volatile("" : "+s"(v));
  return (char*)(GAS char*)v;
}
template <class T>
DI T* gptr(T* p) {
  return (T*)(GAS T*)(unsigned long long)p;
}

constexpr int S_ = 8192, T_ = 16384, DM = 1024, DFF = 2816;
constexpr size_t MiB = 1ull << 20;
constexpr size_t OFF_W = 0, OFF_H = 40 * MiB, OFF_Z = 72 * MiB, OFF_M = 154 * MiB, OFF_X = 218 * MiB;
constexpr size_t OFF_BAR = 240 * MiB;
constexpr size_t WS_NEED = 241 * MiB;
constexpr size_t W_IN = 0;
constexpr size_t W_1K = W_IN + 2688ull * 1024;
constexpr size_t W_1V = W_1K + 256ull * 2048;
constexpr size_t W_2K = W_1V + 256ull * 2048;
constexpr size_t W_2V = W_2K + 128ull * 256;
constexpr size_t W_QUP = W_2V + 128ull * 256;
constexpr size_t W_KVUP = W_QUP + 768ull * 256;
constexpr size_t W_G = W_KVUP + 1024ull * 256;
constexpr size_t W_PA = W_G + 3072ull * 1024;
constexpr size_t W_PB = W_PA + 1024ull * 512;
constexpr size_t W_PC = W_PB + 1024ull * 512;
constexpr size_t W_OUT = W_PC + 1024ull * 512;
constexpr size_t W_GU = W_OUT + 1024ull * 1024;
constexpr size_t W_DOWN = W_GU + 5632ull * 1024;
constexpr size_t W_PLEP = W_DOWN + 1024ull * 2816;
constexpr size_t W_PLEG = W_PLEP + 1024ull * 256;
constexpr size_t W_END = W_PLEG + 1024ull * 1024;
static_assert(W_END * 2 <= 40 * MiB, "weights region");

constexpr float LOG2E = 1.4426950408889634f;
constexpr int SMEM_BYTES = 73728;
constexpr int L_KB = 0, L_VB = 13312, L_IMP = 22528, L_VALS = L_IMP + 2 * 32 * 132 * 4, L_SELM = L_VALS + 32 * 128 * 4, L_UNI = L_SELM + 512;
static_assert(L_UNI + 16 <= SMEM_BYTES, "lds");

struct Params {
  const float* in[29];
  float* out;
  char* ws;
};

typedef __attribute__((ext_vector_type(2))) __bf16 bf2_t;
typedef __attribute__((ext_vector_type(2))) float f2_t;
DI uint32_t pack2(float a, float b) {
  f2_t v = {a, b};
  return __builtin_bit_cast(uint32_t, __builtin_convertvector(v, bf2_t));
}
DI bf16_t f2bf(float x) { return (bf16_t)(pack2(x, 0.f) & 0xffffu); }
DI float bflo(uint32_t v) { return __uint_as_float(v << 16); }
DI float bfhi(uint32_t v) { return __uint_as_float(v & 0xffff0000u); }
DI float sigmoidf_(float x) { return 1.f / (1.f + __expf(-x)); }
DI int lv(int x) {
  asm volatile("" : "+v"(x));
  return x;
}
DI int ls(int x) {
  asm volatile("" : "+s"(x));
  return x;
}
DI float lz0() {
  float z = 0.f;
  asm volatile("" : "+v"(z));
  return z;
}
DI float wave_sum(float v) {
  for (int o = 32; o > 0; o >>= 1) v += __shfl_xor(v, o);
  return v;
}


__device__ const float INVF64[32] = {1.f, 0.749894261f, 0.562341332f, 0.421696514f, 0.316227764f, 0.237137377f, 0.177827939f, 0.133352131f,
    0.100000001f, 0.0749894157f, 0.0562341325f, 0.0421696529f, 0.0316227749f, 0.0237137377f, 0.0177827943f, 0.0133352149f,
    0.00999999978f, 0.00749894185f, 0.00562341325f, 0.00421696482f, 0.00316227763f, 0.00237137359f, 0.00177827943f, 0.00133352145f,
    0.00100000005f, 0.000749894243f, 0.000562341302f, 0.000421696517f, 0.000316227757f, 0.00023713737f, 0.00017782794f, 0.00013335215f};
DI void sincos_acc(float ang, float& c, float& s) {
  const double x = (double)ang;
  const double kd = rint(x * 0.6366197723675814);
  double r = fma(-kd, 1.5707963267948966, x);
  r = fma(-kd, 6.123233995736766e-17, r);
  const int k = (int)kd;
  const double r2 = r * r;
  const double sp = r * (1.0 + r2 * (-1.0 / 6 + r2 * (1.0 / 120 + r2 * (-1.0 / 5040 + r2 * (1.0 / 362880 + r2 * (-1.0 / 39916800 + r2 * (1.0 / 6227020800.0)))))));
  const double cp = 1.0 + r2 * (-0.5 + r2 * (1.0 / 24 + r2 * (-1.0 / 720 + r2 * (1.0 / 40320 + r2 * (-1.0 / 3628800 + r2 * (1.0 / 479001600.0))))));
  const int qd = k & 3;
  const double sv = (qd == 0) ? sp : (qd == 1) ? cp : (qd == 2) ? -sp : -cp;
  const double cv = (qd == 0) ? cp : (qd == 1) ? -sp : (qd == 2) ? -cp : sp;
  s = (float)sv;
  c = (float)cv;
}

template <int NT, bool LEAN = false>
DI void mma_block(const bf16_t* __restrict__ A, int lda, const bf16_t* __restrict__ B, int ldb, int K,
                  f32x16 (&acc)[2][NT], char* smem) {
  constexpr int ASZ = 128 * 144, BSZ = 64 * NT * 144;
  char* As = smem;
  char* Bs = smem + 2 * ASZ;
  const int tid = lv(threadIdx.x), lane = tid & 63, w = tid >> 6, wm = w >> 1, wn = w & 1;
  const int crow = tid >> 3, ccol = tid & 7;
  u32x4 ra0[4], rb0[2 * NT], ra1[4], rb1[2 * NT];
  const unsigned aoff = (unsigned)(crow * lda + ccol * 8) * 2u, astep = (unsigned)lda * 64u;
  const unsigned boff = (unsigned)(crow * ldb + ccol * 8) * 2u, bstep = (unsigned)ldb * 64u;
  const char* Ac = (const char*)A;
  const char* Bc = (const char*)B;
  const int nk = K >> 6;
  const int soff = crow * 144 + ccol * 16;
#define MMA_GLOAD(ra, rb, k0)                                                                        \
  {                                                                                                  \
    _Pragma("unroll") for (int i = 0; i < 4; ++i) ra[i] = *(const u32x4*)(Ac + (size_t)(k0) * 2 + (aoff + i * astep)); \
    _Pragma("unroll") for (int i = 0; i < 2 * NT; ++i) rb[i] = *(const u32x4*)(Bc + (size_t)(k0) * 2 + (boff + i * bstep)); \
  }
#define MMA_SSTORE(ra, rb, buf)                                                                      \
  {                                                                                                  \
    _Pragma("unroll") for (int i = 0; i < 4; ++i) *(u32x4*)(As + (buf) * ASZ + soff + 32 * i * 144) = ra[i]; \
    _Pragma("unroll") for (int i = 0; i < 2 * NT; ++i) *(u32x4*)(Bs + (buf) * BSZ + soff + 32 * i * 144) = rb[i]; \
  }
#define MMA_RDFRAG(buf, ks, fa, fb)                                                                  \
  {                                                                                                  \
    _Pragma("unroll") for (int mi = 0; mi < 2; ++mi) fa[mi] = *(const bf16x8*)(As + (buf) * ASZ + arow + mi * 32 * 144 + (ks) * 32); \
    _Pragma("unroll") for (int ni = 0; ni < NT; ++ni) fb[ni] = *(const bf16x8*)(Bs + (buf) * BSZ + brow + ni * 32 * 144 + (ks) * 32); \
  }
#define MMA_DO(fa, fb)                                                                               \
  {                                                                                                  \
    _Pragma("unroll") for (int mi = 0; mi < 2; ++mi)                                                 \
      _Pragma("unroll") for (int ni = 0; ni < NT; ++ni)                                              \
        acc[mi][ni] = __builtin_amdgcn_mfma_f32_32x32x16_bf16(fa[mi], fb[ni], acc[mi][ni], 0, 0, 0); \
  }
#define MMA_SSTORE_A(ra, buf)                                                                        \
  { _Pragma("unroll") for (int i = 0; i < 4; ++i) *(u32x4*)(As + (buf) * ASZ + soff + 32 * i * 144) = ra[i]; }
#define MMA_SSTORE_B(rb, buf)                                                                        \
  { _Pragma("unroll") for (int i = 0; i < 2 * NT; ++i) *(u32x4*)(Bs + (buf) * BSZ + soff + 32 * i * 144) = rb[i]; }
#define MMA_STEP(buf, sra, srb, dostore, lra, lrb, doload, lk0)                                      \
  {                                                                                                  \
    bf16x8 fa0[2], fb0[NT], fa1[2], fb1[NT];                                                         \
    MMA_RDFRAG(buf, 0, fa0, fb0);                                                                    \
    MMA_RDFRAG(buf, 1, fa1, fb1);                                                                    \
    MMA_DO(fa0, fb0);                                                                                \
    if (doload) MMA_GLOAD(lra, lrb, lk0);                                                            \
    MMA_RDFRAG(buf, 2, fa0, fb0);                                                                    \
    if (dostore) MMA_SSTORE_A(sra, (buf) ^ 1);                                                       \
    MMA_DO(fa1, fb1);                                                                                \
    MMA_RDFRAG(buf, 3, fa1, fb1);                                                                    \
    if (dostore) MMA_SSTORE_B(srb, (buf) ^ 1);                                                       \
    MMA_DO(fa0, fb0);                                                                                \
    MMA_DO(fa1, fb1);                                                                                \
    __builtin_amdgcn_sched_group_barrier(0x100, 2 * (2 + NT), 0);                                    \
    __builtin_amdgcn_sched_group_barrier(0x008, 2 * NT, 0);                                          \
    __builtin_amdgcn_sched_group_barrier(0x020, 4 + 2 * NT, 0);                                      \
    __builtin_amdgcn_sched_group_barrier(0x100, 2 + NT, 0);                                          \
    __builtin_amdgcn_sched_group_barrier(0x200, 4, 0);                                               \
    __builtin_amdgcn_sched_group_barrier(0x008, 2 * NT, 0);                                          \
    __builtin_amdgcn_sched_group_barrier(0x100, 2 + NT, 0);                                          \
    __builtin_amdgcn_sched_group_barrier(0x200, 2 * NT, 0);                                          \
    __builtin_amdgcn_sched_group_barrier(0x008, 2 * NT, 0);                                          \
    __builtin_amdgcn_sched_group_barrier(0x008, 2 * NT, 0);                                          \
  }
#define MMA_STEP_LEAN(buf, sra, srb, dostore, lra, lrb, doload, lk0)                                 \
  {                                                                                                  \
    bf16x8 fa0[2], fb0[NT];                                                                          \
    if (doload) MMA_GLOAD(lra, lrb, lk0);                                                            \
    MMA_RDFRAG(buf, 0, fa0, fb0);                                                                    \
    MMA_DO(fa0, fb0);                                                                                \
    MMA_RDFRAG(buf, 1, fa0, fb0);                                                                    \
    MMA_DO(fa0, fb0);                                                                                \
    if (dostore) MMA_SSTORE_A(sra, (buf) ^ 1);                                                       \
    MMA_RDFRAG(buf, 2, fa0, fb0);                                                                    \
    MMA_DO(fa0, fb0);                                                                                \
    if (dostore) MMA_SSTORE_B(srb, (buf) ^ 1);                                                       \
    MMA_RDFRAG(buf, 3, fa0, fb0);                                                                    \
    MMA_DO(fa0, fb0);                                                                                \
  }
  __syncthreads();
  MMA_GLOAD(ra0, rb0, 0);
  MMA_GLOAD(ra1, rb1, 64);
  MMA_SSTORE(ra0, rb0, 0);
  __syncthreads();
  const int arow = (wm * 64 + (lane & 31)) * 144 + (lane >> 5) * 16;
  const int brow = (wn * 32 * NT + (lane & 31)) * 144 + (lane >> 5) * 16;
  for (int kt = 0; kt < nk; kt += 2) {
    if (LEAN) { MMA_STEP_LEAN(0, ra1, rb1, true, ra0, rb0, (kt + 2 < nk), (kt + 2) << 6); }
    else { MMA_STEP(0, ra1, rb1, true, ra0, rb0, (kt + 2 < nk), (kt + 2) << 6); }
    __syncthreads();
    if (LEAN) { MMA_STEP_LEAN(1, ra0, rb0, (kt + 2 < nk), ra1, rb1, (kt + 3 < nk), (kt + 3) << 6); }
    else { MMA_STEP(1, ra0, rb0, (kt + 2 < nk), ra1, rb1, (kt + 3 < nk), (kt + 3) << 6); }
    __syncthreads();
  }
#undef MMA_RDFRAG
#undef MMA_DO
#undef MMA_SSTORE_A
#undef MMA_SSTORE_B
#undef MMA_STEP
#undef MMA_STEP_LEAN
#undef MMA_GLOAD
#undef MMA_SSTORE
#undef MMA_COMPUTE
}

template <int NT>
DI void zero_acc(f32x16 (&acc)[2][NT]) {
  const float z_ = lz0();
#pragma unroll
  for (int mi = 0; mi < 2; ++mi)
#pragma unroll
    for (int ni = 0; ni < NT; ++ni)
#pragma unroll
      for (int i = 0; i < 16; ++i) acc[mi][ni][i] = z_;
}

template <bool FFN = false>
DI void conv_seg(const float* __restrict__ src, int ldN, int c0, int nc, int K, bf16_t* __restrict__ dst, int r0,
                 int& base, char* smem) {
  float* tile = (float*)smem;
  const int tid = lv(threadIdx.x), G = gridDim.x;
  const int nkt = K >> 6, nnt = (nc + 63) >> 6, total = nkt * nnt;
  int first = ((int)blockIdx.x - (base % G) + G) % G;
  base += total;
  const int r = tid >> 4, c4 = (tid & 15) * 4;
  f32x4 v0, v1, v2, v3;
#define CONV_PREFETCH(tt)                                                                            \
  {                                                                                                  \
    const int kt_ = (tt) % nkt, nt_ = (tt) / nkt;                                                    \
    const int n_ = nt_ * 64 + c4;                                                                    \
    const float* sp_ = src + (size_t)(kt_ * 64 + r) * ldN + c0 + n_;                                 \
    const float zz_ = lz0();                                                                         \
    const f32x4 z_ = {zz_, zz_, zz_, zz_};                                                           \
    v0 = v1 = v2 = v3 = z_;                                                                          \
    if (n_ < nc) {                                                                                   \
      v0 = *(const f32x4*)(sp_);                                                                     \
      v1 = *(const f32x4*)(sp_ + (size_t)16 * ldN);                                                  \
      v2 = *(const f32x4*)(sp_ + (size_t)32 * ldN);                                                  \
      v3 = *(const f32x4*)(sp_ + (size_t)48 * ldN);                                                  \
    }                                                                                                \
  }
  if (first < total) CONV_PREFETCH(first);
  for (int t = first; t < total; t += G) {
    const int kt = t % nkt, nt = t / nkt;
    __syncthreads();
    {
      float* tp = tile + r * 65 + c4;
      tp[0] = v0[0]; tp[1] = v0[1]; tp[2] = v0[2]; tp[3] = v0[3];
      tp += 16 * 65;
      tp[0] = v1[0]; tp[1] = v1[1]; tp[2] = v1[2]; tp[3] = v1[3];
      tp += 16 * 65;
      tp[0] = v2[0]; tp[1] = v2[1]; tp[2] = v2[2]; tp[3] = v2[3];
      tp += 16 * 65;
      tp[0] = v3[0]; tp[1] = v3[1]; tp[2] = v3[2]; tp[3] = v3[3];
    }
    if (t + G < total) CONV_PREFETCH(t + G);
    __syncthreads();
    {
      const int n = tid >> 2, kq = (tid & 3) * 16;
      if (nt * 64 + n < nc) {
        uint32_t o[8];
#pragma unroll
        for (int i = 0; i < 8; ++i) o[i] = pack2(tile[(kq + 2 * i) * 65 + n], tile[(kq + 2 * i + 1) * 65 + n]);
        const int nn = nt * 64 + n;
        const int drow = FFN ? (r0 + (nn >> 5) * 64 + (nn & 31)) : (r0 + nn);
        uint4* dp = (uint4*)(dst + (size_t)drow * K + kt * 64 + kq);
        dp[0] = make_uint4(o[0], o[1], o[2], o[3]);
        dp[1] = make_uint4(o[4], o[5], o[6], o[7]);
      }
    }
  }
}

#undef CONV_PREFETCH
DI void norm_rows_f32(const float* __restrict__ x, const float* __restrict__ gain, bf16_t* __restrict__ dst) {
  const int tid_ = lv(threadIdx.x), lane = tid_ & 63, w = tid_ >> 6;
  for (int row = blockIdx.x * 4 + w; row < T_; row += gridDim.x * 4) {
    const float* xp = x + (size_t)row * DM;
    float4 v[4];
    float ss = 0.f;
#pragma unroll
    for (int i = 0; i < 4; ++i) {
      v[i] = *(const float4*)(xp + i * 256 + lane * 4);
      ss += v[i].x * v[i].x + v[i].y * v[i].y + v[i].z * v[i].z + v[i].w * v[i].w;
    }
    ss = wave_sum(ss);
    const float rs = rsqrtf(ss * (1.f / DM) + 1e-6f);
#pragma unroll
    for (int i = 0; i < 4; ++i) {
      const float4 g = *(const float4*)(gain + i * 256 + lane * 4);
      uint2 o;
      o.x = pack2(v[i].x * rs * g.x, v[i].y * rs * g.y);
      o.y = pack2(v[i].z * rs * g.z, v[i].w * rs * g.w);
      *(uint2*)(dst + (size_t)row * DM + i * 256 + lane * 4) = o;
    }
  }
}

#define KVREGS(name, DQK) u32x4 name##k[(DQK) / 32], name##v[2]

template <int DQK, bool LOADV>
DI void kv_gload_(u32x4 (&rk)[DQK / 32], u32x4 (&rv)[2], const bf16_t* __restrict__ Kt, const bf16_t* __restrict__ Vt, int Sv) {
  const int tid = lv(threadIdx.x);
#pragma unroll
  for (int i = 0; i < DQK / 32; ++i) rk[i] = *(const u32x4*)((const char*)Kt + (size_t)(tid + 256 * i) * 16);
  if (LOADV) {
#pragma unroll
    for (int i = 0; i < 2; ++i) {
      const int c = tid + 256 * i, d = c >> 3, cc = c & 7;
      rv[i] = *(const u32x4*)(Vt + (size_t)d * Sv + cc * 8);
    }
  }
}
template <int DQK, bool LOADV>
DI void kv_sstore_(const u32x4 (&rk)[DQK / 32], const u32x4 (&rv)[2], char* smem) {
  constexpr int CPR = DQK / 8, KSTR = DQK * 2 + 16;
  const int tid = lv(threadIdx.x);
#pragma unroll
  for (int i = 0; i < DQK / 32; ++i) {
    const int c = tid + 256 * i, k = c / CPR, cc = c % CPR;
    const int rho = (k & 32) | (((k >> 2) & 1) << 4) | (((k >> 3) & 3) << 2) | (k & 3);
    *(u32x4*)(smem + L_KB + rho * KSTR + cc * 16) = rk[i];
  }
  if (LOADV) {
#pragma unroll
    for (int i = 0; i < 2; ++i) {
      const int c = tid + 256 * i, d = c >> 3, cc = c & 7;
      *(u32x4*)(smem + L_VB + d * 144 + cc * 16) = rv[i];
    }
  }
}
#define kv_gload(DQK, LV, rg, K, V, SV) kv_gload_<DQK, LV>(rg##k, rg##v, K, V, SV)
#define kv_sstore(DQK, LV, rg, sm) kv_sstore_<DQK, LV>(rg##k, rg##v, sm)

template <int NQ, int KS, int MODE, int MASKMODE>
DI void attn_tile(const char* smem, const bf16x8 (&Qf)[NQ][KS], f32x4 (&O)[NQ][4], float (&m)[NQ], float (&l)[NQ],
                  float sc2, const int (&kmax)[NQ], const int (&kmin)[NQ], float* improw, int Jbase) {
  constexpr int KSTR = KS * 64 + 16;
  const int lane = lv(threadIdx.x) & 63, q = lane & 15, g4 = lane >> 4;
  const char* Kb = smem + L_KB + q * KSTR + g4 * 16;
  const char* Vb = smem + L_VB + q * 144 + g4 * 16;
  f32x4 Sa[NQ][4];
#pragma unroll
  for (int c = 0; c < NQ; ++c)
#pragma unroll
    for (int u = 0; u < 4; ++u) Sa[c][u] = f32x4{0.f, 0.f, 0.f, 0.f};
#pragma unroll
  for (int u = 0; u < 4; ++u)
#pragma unroll
    for (int ks = 0; ks < KS; ++ks) {
      const bf16x8 a = *(const bf16x8*)(Kb + (16 * u) * KSTR + ks * 64);
#pragma unroll
      for (int c = 0; c < NQ; ++c) Sa[c][u] = __builtin_amdgcn_mfma_f32_16x16x32_bf16(a, Qf[c][ks], Sa[c][u], 0, 0, 0);
    }
  bf16x8 Pf[NQ][2];
  float ia[4] = {0.f, 0.f, 0.f, 0.f}, ib[4] = {0.f, 0.f, 0.f, 0.f};
#pragma unroll
  for (int c = 0; c < NQ; ++c) {
    float sv[16];
    const int kx = kmax[c] - 8 * g4, kn = kmin[c] - 8 * g4;
#pragma unroll
    for (int u = 0; u < 4; ++u)
#pragma unroll
      for (int i = 0; i < 4; ++i) {
        const int kc = 32 * (u >> 1) + 4 * (u & 1) + i;
        float v = Sa[c][u][i];
        if (MASKMODE >= 1) v = (kc <= kx) ? v : -1e30f;
        if (MASKMODE == 2) v = (kc >= kn) ? v : -1e30f;
        sv[4 * u + i] = v;
      }
    float p[16];
    if (MODE == 2) {
      const float msc = m[c] * sc2;
#pragma unroll
      for (int e = 0; e < 16; ++e) p[e] = __builtin_amdgcn_exp2f(fmaf(sv[e], sc2, -msc)) * l[c];
#pragma unroll
      for (int u = 0; u < 4; ++u) {
        ia[u] += p[4 * u] + p[4 * u + 1] + p[4 * u + 2] + 0.5f * p[4 * u + 3];
        ib[u] += 0.5f * p[4 * u + 3];
      }
    } else {
      float mx = sv[0];
#pragma unroll
      for (int e = 1; e < 16; ++e) mx = fmaxf(mx, sv[e]);
      mx = fmaxf(mx, __shfl_xor(mx, 16));
      mx = fmaxf(mx, __shfl_xor(mx, 32));
      const float mn = fmaxf(m[c], mx);
      const float alpha = __builtin_amdgcn_exp2f((m[c] - mn) * sc2);
      m[c] = mn;
      const float msc = mn * sc2;
      float rs = 0.f;
#pragma unroll
      for (int e = 0; e < 16; ++e) {
        p[e] = __builtin_amdgcn_exp2f(fmaf(sv[e], sc2, -msc));
        rs += p[e];
      }
      l[c] = l[c] * alpha + rs;
      if (MODE == 0) {
#pragma unroll
        for (int dt = 0; dt < 4; ++dt) O[c][dt] *= alpha;
      }
    }
    if (MODE != 1) {
#pragma unroll
      for (int hf = 0; hf < 2; ++hf) {
        uint32_t pk[4];
#pragma unroll
        for (int j = 0; j < 4; ++j) pk[j] = pack2(p[8 * hf + 2 * j], p[8 * hf + 2 * j + 1]);
        Pf[c][hf] = __builtin_bit_cast(bf16x8, u32x4{pk[0], pk[1], pk[2], pk[3]});
      }
    }
  }
  if (MODE == 2) {
#pragma unroll
    for (int hf = 0; hf < 2; ++hf) {
      const int J = Jbase + 8 * hf + 2 * g4;
      improw[J] += ia[2 * hf];
      improw[J + 1] += ia[2 * hf + 1];
      __builtin_amdgcn_fence(__ATOMIC_SEQ_CST, "wavefront");
      improw[J + 1] += ib[2 * hf];
      improw[J + 2] += ib[2 * hf + 1];
      __builtin_amdgcn_fence(__ATOMIC_SEQ_CST, "wavefront");
    }
  }
  if (MODE != 1) {
#pragma unroll
    for (int hf = 0; hf < 2; ++hf)
#pragma unroll
      for (int dt = 0; dt < 4; ++dt) {
        const bf16x8 a = *(const bf16x8*)(Vb + dt * 16 * 144 + hf * 64);
#pragma unroll
        for (int c = 0; c < NQ; ++c) O[c][dt] = __builtin_amdgcn_mfma_f32_16x16x32_bf16(a, Pf[c][hf], O[c][dt], 0, 0, 0);
      }
  }
}

template <int NQ>
DI void attn_finish(f32x4 (&O)[NQ][4], float (&l)[NQ]) {
#pragma unroll
  for (int c = 0; c < NQ; ++c) {
    float t = l[c];
    t += __shfl_xor(t, 16);
    t += __shfl_xor(t, 32);
    l[c] = t > 0.f ? 1.f / t : 0.f;
  }
}

DI void nsa_item(const Params& P, char* ws, int b, int g, int ch, char* smem) {
  bf16_t* AQ = (bf16_t*)(ws + OFF_Z);
  const bf16_t* AKS = (const bf16_t*)(ws + OFF_Z + 24 * MiB);
  const bf16_t* AVST = (const bf16_t*)(ws + OFF_Z + 28 * MiB);
  const bf16_t* AKW = (const bf16_t*)(ws + OFF_Z + 32 * MiB);
  const bf16_t* AVWT = (const bf16_t*)(ws + OFF_Z + 36 * MiB);
  const float* AG = (const float*)(ws + OFF_Z + 80 * MiB);
  const bf16_t* KCMP = (const bf16_t*)(ws + OFF_X + 8 * MiB);
  const bf16_t* VCMPT = (const bf16_t*)(ws + OFF_X + 8 * MiB + 256 * 1024);
  const int tid = lv(threadIdx.x), lane = tid & 63, w = tid >> 6, q = lane & 15, g4 = lane >> 4;
  const int sub = w & 1, hp = w >> 1;
  const int t0 = ch * 32, tq = t0 + 16 * sub + q;
  const size_t tokrow = (size_t)b * S_ + tq;
  const int bg = b * 2 + g;
  const int h0 = g * 4 + 2 * hp;
  bf16x8 Qf[2][2];
#pragma unroll
  for (int c = 0; c < 2; ++c)
#pragma unroll
    for (int ks = 0; ks < 2; ++ks) Qf[c][ks] = *(const bf16x8*)(AQ + (tokrow * 8 + h0 + c) * 64 + ks * 32 + g4 * 8);
  const float* gap = AG + tokrow * 24 + h0 * 3;
  float* imp = (float*)(smem + L_IMP);
  unsigned short* selm = (unsigned short*)(smem + L_SELM);
  unsigned* uni = (unsigned*)(smem + L_UNI);
  __syncthreads();
  for (int i = tid; i < 2 * 32 * 132; i += 256) imp[i] = 0.f;
  if (tid < 4) uni[tid] = 0u;
  const float sc2 = 0.125f * LOG2E;
  const bf16_t* Kc = KCMP + (size_t)bg * 512 * 64;
  const bf16_t* Vc = VCMPT + (size_t)bg * 64 * 512;
  const int nct = ((t0 >> 4) + 1 + 63) >> 6;
  float m[2] = {-1e28f, -1e28f}, l[2] = {0.f, 0.f};
  f32x4 O[2][4];
  f32x4 Ot[2][4];
#pragma unroll
  for (int c = 0; c < 2; ++c)
#pragma unroll
    for (int dt = 0; dt < 4; ++dt) { const float z_ = lz0(); O[c][dt] = f32x4{z_, z_, z_, z_}; }
  KVREGS(rg, 64);
  kv_gload(64, false, rg, Kc, Vc, 512);
  for (int tile = 0; tile < nct; ++tile) {
    __syncthreads();
    kv_sstore(64, false, rg, smem);
    __syncthreads();
    if (tile + 1 < nct) kv_gload(64, false, rg, Kc + (size_t)(tile + 1) * 64 * 64, Vc, 512);
    const int kx_ = ((tq - 31) >> 4) - 64 * tile;
    const int kmx[2] = {kx_, kx_}, kmn[2] = {0, 0};
    attn_tile<2, 2, 1, 1>(smem, Qf, O, m, l, sc2, kmx, kmn, nullptr, 0);
  }
  attn_finish<2>(O, l);
  kv_gload(64, true, rg, Kc, Vc, 512);
  float* improw = imp + (hp * 32 + 16 * sub + q) * 132;
  for (int tile = 0; tile < nct; ++tile) {
    __syncthreads();
    kv_sstore(64, true, rg, smem);
    __syncthreads();
    if (tile + 1 < nct) kv_gload(64, true, rg, Kc + (size_t)(tile + 1) * 64 * 64, Vc + (tile + 1) * 64, 512);
    const int kx_ = ((tq - 31) >> 4) - 64 * tile;
    const int kmx[2] = {kx_, kx_}, kmn[2] = {0, 0};
    attn_tile<2, 2, 2, 1>(smem, Qf, O, m, l, sc2, kmx, kmn, improw, tile * 16);
  }
#pragma unroll
  for (int c = 0; c < 2; ++c)
#pragma unroll
    for (int dt = 0; dt < 4; ++dt) Ot[c][dt] = O[c][dt] * gap[c * 3];
  __syncthreads();
  const int cur = t0 >> 6;
  {
    const int tok = tid >> 3, s8 = tid & 7;
    const float* i0 = imp + tok * 132;
    const float* i1 = imp + (32 + tok) * 132;
    unsigned mask16 = 0;
    if (cur < 16) {
#pragma unroll
      for (int jj = 0; jj < 16; ++jj) mask16 |= ((s8 * 16 + jj) <= cur) ? (1u << jj) : 0u;
    } else {
      unsigned long long key[16];
#pragma unroll
      for (int jj = 0; jj < 16; ++jj) {
        const int j = s8 * 16 + jj;
        const float v = (i0[j] + i1[j]) + ((j == 0 || j == cur || j == cur - 1) ? 1e4f : 0.f);
        const unsigned kb = (j <= cur) ? (__float_as_uint(v) + 1u) : 0u;
        key[jj] = ((unsigned long long)kb << 8) | (unsigned long long)(127 - j);
      }
#pragma unroll 1
      for (int r = 0; r < 16; ++r) {
        unsigned long long mx = key[0];
#pragma unroll
        for (int jj = 1; jj < 16; ++jj) mx = key[jj] > mx ? key[jj] : mx;
#pragma unroll
        for (int o = 1; o < 8; o <<= 1) {
          const unsigned long long ot = __shfl_xor(mx, o);
          mx = ot > mx ? ot : mx;
        }
#pragma unroll
        for (int jj = 0; jj < 16; ++jj) {
          const bool hit = key[jj] == mx;
          mask16 |= hit ? (1u << jj) : 0u;
          key[jj] = hit ? 0ull : key[jj];
        }
      }
    }
    selm[tok * 8 + s8] = (unsigned short)mask16;
    if (mask16) atomicOr(&uni[s8 >> 1], mask16 << ((s8 & 1) * 16));
  }
  __syncthreads();
  unsigned mkb[4], un[4];
  {
    const unsigned short* sm = selm + (16 * sub + q) * 8;
#pragma unroll
    for (int i = 0; i < 4; ++i) {
      mkb[i] = (unsigned)sm[2 * i] | ((unsigned)sm[2 * i + 1] << 16);
      un[i] = uni[i];
    }
  }
  {
    const bf16_t* Ks = AKS + (size_t)bg * S_ * 64;
    const bf16_t* Vs = AVST + (size_t)bg * 64 * S_;
    m[0] = m[1] = -1e28f;
    l[0] = l[1] = 0.f;
#pragma unroll
    for (int c = 0; c < 2; ++c)
#pragma unroll
      for (int dt = 0; dt < 4; ++dt) { const float z_ = lz0(); O[c][dt] = f32x4{z_, z_, z_, z_}; }
    auto nextset = [&](int from) {
      for (int j = from; j <= cur; ++j)
        if ((un[j >> 5] >> (j & 31)) & 1u) return j;
      return -1;
    };
    int j = nextset(0);
    if (j >= 0) kv_gload(64, true, rg, Ks + (size_t)j * 64 * 64, Vs + j * 64, S_);
    while (j >= 0) {
      __syncthreads();
      kv_sstore(64, true, rg, smem);
      __syncthreads();
      const int jn = nextset(j + 1);
      if (jn >= 0) kv_gload(64, true, rg, Ks + (size_t)jn * 64 * 64, Vs + jn * 64, S_);
      const bool bit = (mkb[j >> 5] >> (j & 31)) & 1u;
      if (__ballot(bit) != 0ull) {
        const int kx_ = bit ? (tq - 64 * j) : -1;
        const int kmx[2] = {kx_, kx_}, kmn[2] = {0, 0};
        attn_tile<2, 2, 0, 1>(smem, Qf, O, m, l, sc2, kmx, kmn, nullptr, 0);
      }
      j = jn;
    }
    attn_finish<2>(O, l);
#pragma unroll
    for (int c = 0; c < 2; ++c)
#pragma unroll
      for (int dt = 0; dt < 4; ++dt) Ot[c][dt] += O[c][dt] * (l[c] * gap[c * 3 + 1]);
  }
  {
    const bf16_t* Kw = AKW + (size_t)bg * S_ * 64;
    const bf16_t* Vw = AVWT + (size_t)bg * 64 * S_;
    m[0] = m[1] = -1e28f;
    l[0] = l[1] = 0.f;
#pragma unroll
    for (int c = 0; c < 2; ++c)
#pragma unroll
      for (int dt = 0; dt < 4; ++dt) { const float z_ = lz0(); O[c][dt] = f32x4{z_, z_, z_, z_}; }
    int jlo = (t0 - 511) >> 6;
    if (jlo < 0) jlo = 0;
    const int jhi = t0 >> 6;
    kv_gload(64, true, rg, Kw + (size_t)jlo * 64 * 64, Vw + jlo * 64, S_);
    for (int j = jlo; j <= jhi; ++j) {
      __syncthreads();
      kv_sstore(64, true, rg, smem);
      __syncthreads();
      if (j + 1 <= jhi) kv_gload(64, true, rg, Kw + (size_t)(j + 1) * 64 * 64, Vw + (j + 1) * 64, S_);
      const int kx_ = tq - 64 * j, kn_ = tq - 511 - 64 * j;
      const int kmx[2] = {kx_, kx_}, kmn[2] = {kn_, kn_};
      attn_tile<2, 2, 0, 2>(smem, Qf, O, m, l, sc2, kmx, kmn, nullptr, 0);
    }
    attn_finish<2>(O, l);
#pragma unroll
    for (int c = 0; c < 2; ++c)
#pragma unroll
      for (int dt = 0; dt < 4; ++dt) Ot[c][dt] += O[c][dt] * (l[c] * gap[c * 3 + 2]);
  }
#pragma unroll
  for (int c = 0; c < 2; ++c)
#pragma unroll
    for (int dt = 0; dt < 4; ++dt) {
      uint2 o;
      o.x = pack2(Ot[c][dt][0], Ot[c][dt][1]);
      o.y = pack2(Ot[c][dt][2], Ot[c][dt][3]);
      *(uint2*)(AQ + (tokrow * 8 + h0 + c) * 64 + dt * 16 + 4 * g4) = o;
    }
}

DI void swa_item(const Params& P, char* ws, int layer, int b, int g, int ch, char* smem) {
  bf16_t* BQ = (bf16_t*)(ws + OFF_Z + 40 * MiB);
  const bf16_t* BK = (const bf16_t*)(ws + OFF_Z + 56 * MiB);
  const bf16_t* BVT = (const bf16_t*)(ws + OFF_Z + 60 * MiB);
  const float* sinks = gptr(P.in[11]) + layer * 8;
  const int tid = lv(threadIdx.x), lane = tid & 63, w = tid >> 6, q = lane & 15, g4 = lane >> 4;
  const int sub = w & 1, hp = w >> 1;
  const int t0 = ch * 32, tq = t0 + 16 * sub + q;
  const size_t tokrow = (size_t)b * S_ + tq;
  const int bg = b * 2 + g;
  const int h0 = g * 4 + 2 * hp;
  bf16x8 Qf[2][2];
#pragma unroll
  for (int c = 0; c < 2; ++c)
#pragma unroll
    for (int ks = 0; ks < 2; ++ks) Qf[c][ks] = *(const bf16x8*)(BQ + (tokrow * 8 + h0 + c) * 64 + ks * 32 + g4 * 8);
  const float sc2 = 0.125f * LOG2E;
  float m[2], l[2];
  f32x4 O[2][4];
#pragma unroll
  for (int c = 0; c < 2; ++c) {
    m[c] = sinks[h0 + c] * 8.f;
    l[c] = (g4 == 0) ? 1.f : 0.f;
#pragma unroll
    for (int dt = 0; dt < 4; ++dt) { const float z_ = lz0(); O[c][dt] = f32x4{z_, z_, z_, z_}; }
  }
  const bf16_t* Kb = BK + (size_t)bg * S_ * 64;
  const bf16_t* Vb = BVT + (size_t)bg * 64 * S_;
  int jlo = (t0 - 127) >> 6;
  if (jlo < 0) jlo = 0;
  const int jhi = t0 >> 6;
  KVREGS(rg, 64);
  kv_gload(64, true, rg, Kb + (size_t)jlo * 64 * 64, Vb + jlo * 64, S_);
  for (int j = jlo; j <= jhi; ++j) {
    __syncthreads();
    kv_sstore(64, true, rg, smem);
    __syncthreads();
    if (j + 1 <= jhi) kv_gload(64, true, rg, Kb + (size_t)(j + 1) * 64 * 64, Vb + (j + 1) * 64, S_);
    const int kx_ = tq - 64 * j, kn_ = tq - 127 - 64 * j;
    const int kmx[2] = {kx_, kx_}, kmn[2] = {kn_, kn_};
    attn_tile<2, 2, 0, 2>(smem, Qf, O, m, l, sc2, kmx, kmn, nullptr, 0);
  }
  attn_finish<2>(O, l);
#pragma unroll
  for (int c = 0; c < 2; ++c)
#pragma unroll
    for (int dt = 0; dt < 4; ++dt) {
      uint2 o;
      o.x = pack2(O[c][dt][0] * l[c], O[c][dt][1] * l[c]);
      o.y = pack2(O[c][dt][2] * l[c], O[c][dt][3] * l[c]);
      *(uint2*)(BQ + (tokrow * 8 + h0 + c) * 64 + dt * 16 + 4 * g4) = o;
    }
}

DI void mla_item(const Params& P, char* ws, int b, int h, int qb, char* smem) {
  const bf16_t* CQF = (const bf16_t*)(ws + OFF_M);
  const bf16_t* CK = (const bf16_t*)(ws + OFF_M + 24 * MiB);
  const bf16_t* CVT = (const bf16_t*)(ws + OFF_M + 48 * MiB);
  bf16_t* OC = (bf16_t*)(ws + OFF_Z + 64 * MiB);
  const int tid = lv(threadIdx.x), lane = tid & 63, w = tid >> 6, q = lane & 15, g4 = lane >> 4;
  const int t0 = qb * 128;
  int tq[2];
  bf16x8 Qf[2][3];
#pragma unroll
  for (int c = 0; c < 2; ++c) {
    tq[c] = t0 + 32 * w + 16 * c + q;
#pragma unroll
    for (int ks = 0; ks < 3; ++ks)
      Qf[c][ks] = *(const bf16x8*)(CQF + (((size_t)b * S_ + tq[c]) * 8 + h) * 96 + ks * 32 + g4 * 8);
  }
  const float sc2 = 0.10206207261596575f * LOG2E;
  float m[2] = {-1e28f, -1e28f}, l[2] = {0.f, 0.f};
  f32x4 O[2][4];
#pragma unroll
  for (int c = 0; c < 2; ++c)
#pragma unroll
    for (int dt = 0; dt < 4; ++dt) { const float z_ = lz0(); O[c][dt] = f32x4{z_, z_, z_, z_}; }
  const bf16_t* Kb = CK + (size_t)(b * 8 + h) * S_ * 96;
  const bf16_t* Vb = CVT + (size_t)(b * 8 + h) * 64 * S_;
  const int ntile = 2 * qb + 2;
  const int wmax = t0 + 32 * w + 31, wmin = t0 + 32 * w;
  KVREGS(rg, 96);
  kv_gload(96, true, rg, Kb, Vb, S_);
  for (int j = 0; j < ntile; ++j) {
    __syncthreads();
    kv_sstore(96, true, rg, smem);
    __syncthreads();
    if (j + 1 < ntile) kv_gload(96, true, rg, Kb + (size_t)(j + 1) * 64 * 96, Vb + (j + 1) * 64, S_);
    if (j * 64 <= wmax) {
      const int kmx[2] = {tq[0] - 64 * j, tq[1] - 64 * j}, kmn[2] = {0, 0};
      if (j * 64 + 63 <= wmin) attn_tile<2, 3, 0, 0>(smem, Qf, O, m, l, sc2, kmx, kmn, nullptr, 0);
      else attn_tile<2, 3, 0, 1>(smem, Qf, O, m, l, sc2, kmx, kmn, nullptr, 0);
    }
  }
  attn_finish<2>(O, l);
#pragma unroll
  for (int c = 0; c < 2; ++c)
#pragma unroll
    for (int dt = 0; dt < 4; ++dt) {
      uint2 o;
      o.x = pack2(O[c][dt][0] * l[c], O[c][dt][1] * l[c]);
      o.y = pack2(O[c][dt][2] * l[c], O[c][dt][3] * l[c]);
      *(uint2*)(OC + ((size_t)b * S_ + tq[c]) * 512 + h * 64 + dt * 16 + 4 * g4) = o;
    }
}

#define XB_TMO      128
#define XB_XCNT(j)  (256  + 64 * (j))
#define XB_XSUB(j)  (1280 + 64 * (j))
#define XB_XGEN(j)  (2304 + 64 * (j))
#define XB_TOP      3328
#define XB_TOPGEN   3392
#define XCD_BAR_WORDS 3456
#define XB_SPIN_CAP (1u << 18)
#define LAS __attribute__((address_space(3)))

__device__ __forceinline__ unsigned xb_ld(unsigned* p)              { return __hip_atomic_load(p, __ATOMIC_RELAXED, __HIP_MEMORY_SCOPE_AGENT); }
__device__ __forceinline__ unsigned xb_add(unsigned* p, unsigned v) { return __hip_atomic_fetch_add(p, v, __ATOMIC_RELAXED, __HIP_MEMORY_SCOPE_AGENT); }
__device__ __forceinline__ unsigned xb_xcc_id() { return (unsigned)__builtin_amdgcn_s_getreg((3 << 11) | 20) & 0xFu; }
#define XB_SPIN(cond, bar) do { unsigned _sp = 0; while (cond) { __builtin_amdgcn_s_sleep(1); \
    if ((++_sp & 255u) == 0u) { if (xb_ld(&(bar)[XB_TMO])) break; if (_sp > XB_SPIN_CAP) { atomicAdd(&(bar)[XB_TMO], 1u); break; } } } } while (0)

struct XcdBarrier {
    unsigned* bar; unsigned x;
    volatile LAS unsigned* st;
};

__device__ __forceinline__ XcdBarrier xcd_barrier_post(unsigned* bar, volatile LAS unsigned* st) {
    XcdBarrier b; b.bar = bar; b.x = xb_xcc_id(); b.st = st;
    if (threadIdx.x == 0) (void)xb_add(&bar[XB_XCNT(b.x)], 1u);
    return b;
}
__device__ __forceinline__ void xcd_barrier_complete(unsigned* bar, unsigned x, unsigned& nloc, unsigned& nx) {
    const unsigned G = gridDim.x * gridDim.y * gridDim.z;
    unsigned sum, cnt, mine, sp = 0u;
    for (;;) {
        sum = 0u; cnt = 0u; mine = 0u;
#pragma unroll
        for (unsigned j = 0; j < 16; ++j) { const unsigned c = xb_ld(&bar[XB_XCNT(j)]); sum += c; cnt += (c > 0u) ? 1u : 0u; mine = (j == x) ? c : mine; }
        if (sum == G) break;
        __builtin_amdgcn_s_sleep(1);
        if ((++sp & 255u) == 0u) { if (xb_ld(&bar[XB_TMO])) break; if (sp > XB_SPIN_CAP) { atomicAdd(&bar[XB_TMO], 1u); break; } }
    }
    nloc = mine > 0u ? mine : 1u; nx = cnt > 0u ? cnt : 1u;
}

__device__ __forceinline__ void xcd_barrier(const XcdBarrier& b) {
    asm volatile("s_waitcnt vmcnt(0)" ::: "memory");
    __syncthreads();
    if (threadIdx.x == 0) {
        unsigned* bar = b.bar;
        const unsigned bx_ = xb_xcc_id();
        __builtin_amdgcn_s_waitcnt(0);
        unsigned nloc = b.st[0], nx = b.st[1];
        if (nloc == 0u) { xcd_barrier_complete(bar, bx_, nloc, nx); b.st[0] = nloc; b.st[1] = nx; }
        const unsigned old = xb_add(&bar[XB_XSUB(bx_)], 1u);
        const unsigned gen = old / nloc;
        if (old + 1u == (gen + 1u) * nloc) {
            __builtin_amdgcn_fence(__ATOMIC_RELEASE, "agent");
            asm volatile("s_waitcnt vmcnt(0)" ::: "memory");
            const unsigned og = xb_add(&bar[XB_TOP], 1u);
            const unsigned tg = og / nx;
            if (og + 1u == (tg + 1u) * nx) xb_add(&bar[XB_TOPGEN], 1u);
            else XB_SPIN(xb_ld(&bar[XB_TOPGEN]) == tg, bar);
            __builtin_amdgcn_fence(__ATOMIC_ACQUIRE, "agent");
            xb_add(&bar[XB_XGEN(bx_)], 1u);
            asm volatile("s_waitcnt vmcnt(0)" ::: "memory");
        } else {
            XB_SPIN(xb_ld(&bar[XB_XGEN(bx_)]) == gen, bar);
            __builtin_amdgcn_fence(__ATOMIC_ACQUIRE, "agent");
            asm volatile("s_waitcnt vmcnt(0)" ::: "memory");
        }
    }
    __syncthreads();
}


DI void tile_map(int q, int Nt, bool xcd, int& mt, int& nt) {
  if (!xcd) { mt = q / Nt; nt = q % Nt; return; }
  const int c = q >> 7;
  int ml, nl, mg;
  if (8 * c + 8 <= Nt) {
    const int r = q & 127;
    ml = r & 7; nl = (r >> 3) & 7; mg = r >> 6;
  } else {
    const int wN = Nt - 8 * c, r = q - 128 * c, rest = r >> 3;
    ml = r & 7; nl = rest % wN; mg = rest / wN;
  }
  mt = 16 * (int)(blockIdx.x & 7) + 8 * mg + ml;
  nt = 8 * c + nl;
}
#define TILE_LOOP(Nt) for (int q_ = (xcdmap ? (int)(blockIdx.x >> 3) : vbid); q_ < (xcdmap ? 16 * (Nt) : 128 * (Nt)); q_ += (xcdmap ? 64 : G))

#define DECL_PTRS \
  bf16_t* Wb = (bf16_t*)(ws + OFF_W); \
  bf16_t* H = (bf16_t*)(ws + OFF_H); \
  bf16_t* AQ = (bf16_t*)(ws + OFF_Z); \
  bf16_t* AKC = (bf16_t*)(ws + OFF_Z + 16 * MiB); \
  bf16_t* BQ = (bf16_t*)(ws + OFF_Z + 40 * MiB); \
  bf16_t* BK = (bf16_t*)(ws + OFF_Z + 56 * MiB); \
  bf16_t* BVT = (bf16_t*)(ws + OFF_Z + 60 * MiB); \
  bf16_t* CQ = (bf16_t*)(ws + OFF_Z + 64 * MiB); \
  bf16_t* CKV = (bf16_t*)(ws + OFF_Z + 72 * MiB); \
  float* AG = (float*)(ws + OFF_Z + 80 * MiB); \
  bf16_t* CQF = (bf16_t*)(ws + OFF_M); \
  bf16_t* CK = (bf16_t*)(ws + OFF_M + 24 * MiB); \
  bf16_t* CVT = (bf16_t*)(ws + OFF_M + 48 * MiB); \
  bf16_t* MERGED = (bf16_t*)(ws + OFF_M); \
  bf16_t* ACT = (bf16_t*)(ws + OFF_Z); \
  float* COS64 = (float*)(ws + OFF_X); \
  float* SIN64 = (float*)(ws + OFF_X + 2 * MiB); \
  float* COS32 = (float*)(ws + OFF_X + 4 * MiB); \
  float* SIN32 = (float*)(ws + OFF_X + 5 * MiB); \
  bf16_t* HID = (bf16_t*)(ws + OFF_X + 6 * MiB); \
  bf16_t* KCMP = (bf16_t*)(ws + OFF_X + 8 * MiB); \
  bf16_t* VCMPT = (bf16_t*)(ws + OFF_X + 8 * MiB + 256 * 1024); \
  float* BIAS = (float*)(ws + OFF_X + 8 * MiB + 512 * 1024); \
  bf16_t* PB = (bf16_t*)(ws + OFF_X + 10 * MiB);

__global__ void __launch_bounds__(256, 2) mega(Params P) {
  cg::grid_group grid = cg::this_grid();
  __shared__ __attribute__((aligned(16))) char smem[SMEM_BYTES];
  char* ws0 = P.ws;
  __shared__ uint4 xb_words;
  if (threadIdx.x == 0) xb_words = make_uint4(0u, 0u, 0u, 0u);
  __syncthreads();
  if (P.ws == nullptr) grid.sync();
  const XcdBarrier xb = xcd_barrier_post((unsigned*)(ws0 + OFF_BAR), (volatile LAS unsigned*)&xb_words);
  const int G = gridDim.x;
  const bool xcdmap = (G == 512);
  const int vbid = (G & 7) ? (int)blockIdx.x : (int)((blockIdx.x & 7) * (G >> 3) + (blockIdx.x >> 3));

  float* xo = gptr(P.out);

  {
    char* ws = launder(ws0);
    DECL_PTRS
    const int tid = lv(threadIdx.x);
    const int gtid = blockIdx.x * 256 + tid, gthreads = ls(G) * 256;
    (void)Wb; (void)H;
        const int* posi = (const int*)gptr(P.in[2]);
        for (int i = gtid; i < T_ * 32; i += gthreads) {
          const int t = i >> 5, ff = i & 31;
          float c, sn;
          sincos_acc((float)posi[t] * INVF64[ff], c, sn);
          COS64[i] = c;
          SIN64[i] = sn;
        }
        for (int i = gtid; i < T_ * 16; i += gthreads) {
          const int t = i >> 4, ff = i & 15;
          float c, sn;
          sincos_acc((float)posi[t] * INVF64[2 * ff], c, sn);
          COS32[i] = c;
          SIN32[i] = sn;
        }
      }
  for (int layer = 0; layer < 2; ++layer) {
    const float* xi = layer == 0 ? gptr(P.in[0]) : (const float*)gptr(P.out);
    {
      char* ws = launder(ws0);
      DECL_PTRS
      const int tid = lv(threadIdx.x), lane = tid & 63, w = tid >> 6, wm = w >> 1, wn = w & 1, f = lane & 31, hi = lane >> 5;
      const int gtid = blockIdx.x * 256 + tid, gthreads = ls(G) * 256;
      (void)wm; (void)wn; (void)f; (void)hi; (void)gtid; (void)gthreads; (void)w;
    {
      int base = 0;
      const float* w_in = gptr(P.in[4]) + (size_t)layer * 1024 * 2616;
      conv_seg(w_in, 2616, 0, 1280, 1024, Wb + W_IN, 0, base, smem);
      conv_seg(w_in, 2616, 1304, 1312, 1024, Wb + W_IN, 1280, base, smem);
      conv_seg(w_in, 2616, 1280, 24, 1024, Wb + W_IN, 2592, base, smem);
      conv_seg(gptr(P.in[6]) + (size_t)layer * 2048 * 256, 256, 0, 256, 2048, Wb + W_1K, 0, base, smem);
      conv_seg(gptr(P.in[9]) + (size_t)layer * 2048 * 256, 256, 0, 256, 2048, Wb + W_1V, 0, base, smem);
      conv_seg(gptr(P.in[7]) + (size_t)layer * 256 * 64, 64, 0, 64, 256, Wb + W_2K, 0, base, smem);
      conv_seg(gptr(P.in[10]) + (size_t)layer * 256 * 64, 64, 0, 64, 256, Wb + W_2V, 0, base, smem);
      {
        const float* wq = gptr(P.in[13]) + (size_t)layer * 256 * 768;
        const float* wkv = gptr(P.in[15]) + (size_t)layer * 256 * 1024;
        for (int h = 0; h < 8; ++h) {
          conv_seg(wq, 768, h * 96, 64, 256, Wb + W_QUP, h * 64, base, smem);
          conv_seg(wq, 768, h * 96 + 64, 32, 256, Wb + W_QUP, 512 + h * 32, base, smem);
          conv_seg(wkv, 1024, h * 128, 64, 256, Wb + W_KVUP, h * 64, base, smem);
          conv_seg(wkv, 1024, h * 128 + 64, 64, 256, Wb + W_KVUP, 512 + h * 64, base, smem);
        }
      }
      conv_seg(gptr(P.in[16]) + (size_t)layer * 1024 * 3072, 3072, 0, 3072, 1024, Wb + W_G, 0, base, smem);
      conv_seg(gptr(P.in[17]) + (size_t)layer * 512 * 1024, 1024, 0, 1024, 512, Wb + W_PA, 0, base, smem);
      conv_seg(gptr(P.in[18]) + (size_t)layer * 512 * 1024, 1024, 0, 1024, 512, Wb + W_PB, 0, base, smem);
      conv_seg(gptr(P.in[19]) + (size_t)layer * 512 * 1024, 1024, 0, 1024, 512, Wb + W_PC, 0, base, smem);
      conv_seg(gptr(P.in[20]) + (size_t)layer * 1024 * 1024, 1024, 0, 1024, 1024, Wb + W_OUT, 0, base, smem);
      {
        const float* wg = gptr(P.in[22]) + (size_t)layer * 1024 * DFF;
        const float* wu = gptr(P.in[23]) + (size_t)layer * 1024 * DFF;
        conv_seg<true>(wg, DFF, 0, DFF, 1024, Wb + W_GU, 0, base, smem);
        conv_seg<true>(wu, DFF, 0, DFF, 1024, Wb + W_GU, 32, base, smem);
      }
      conv_seg(gptr(P.in[24]) + (size_t)layer * DFF * 1024, 1024, 0, 1024, DFF, Wb + W_DOWN, 0, base, smem);
      conv_seg(gptr(P.in[26]) + (size_t)layer * 256 * 1024, 1024, 0, 1024, 256, Wb + W_PLEP, 0, base, smem);
      conv_seg(gptr(P.in[27]) + (size_t)layer * 1024 * 1024, 1024, 0, 1024, 1024, Wb + W_PLEG, 0, base, smem);
      const unsigned zu_ = (unsigned)lv(0);
      for (int i = gtid; i < 72 * 1024 / 8; i += gthreads) ((uint4*)(Wb + W_IN + 2616ull * 1024))[i] = make_uint4(zu_, zu_, zu_, zu_);
      for (int i = gtid; i < 2 * 64 * 256 / 8; i += gthreads) {
        const int which = i / (64 * 256 / 8), r = i % (64 * 256 / 8);
        ((uint4*)(Wb + (which ? W_2V : W_2K) + 64ull * 256))[r] = make_uint4(zu_, zu_, zu_, zu_);
      }
      __syncthreads();
      if (blockIdx.x < 16) {
        const int which = blockIdx.x >> 3, part = blockIdx.x & 7;
        const float* pos = gptr(P.in[which ? 8 : 5]) + (size_t)layer * 2048;
        const float* w1 = gptr(P.in[which ? 9 : 6]) + (size_t)layer * 2048 * 256;
        const int c = tid & 31, ks = tid >> 5;
        float sacc = 0.f;
        for (int k = ks * 256; k < ks * 256 + 256; ++k) sacc += pos[k] * w1[(size_t)k * 256 + part * 32 + c];
        float* red = (float*)smem;
        red[tid] = sacc;
        __syncthreads();
        if (tid < 32) {
          float t = 0.f;
          for (int i = 0; i < 8; ++i) t += red[i * 32 + tid];
          BIAS[which * 256 + part * 32 + tid] = t;
        }
      }
      {
        const float* pp = gptr(P.in[1]) + (size_t)layer * T_ * 256;
        for (int i = gtid; i < T_ * 256 / 4; i += gthreads) {
          const float4 v = ((const float4*)pp)[i];
          uint2 o;
          o.x = pack2(v.x, v.y);
          o.y = pack2(v.z, v.w);
          ((uint2*)PB)[i] = o;
        }
      }
      norm_rows_f32(xi, gptr(P.in[3]) + layer * DM, H);
    }
    }
    xcd_barrier(xb);
    {
      char* ws = launder(ws0);
      DECL_PTRS
      const int tid = lv(threadIdx.x), lane = tid & 63, w = tid >> 6, wm = w >> 1, wn = w & 1, f = lane & 31, hi = lane >> 5;
      const int gtid = blockIdx.x * 256 + tid, gthreads = ls(G) * 256;
      (void)wm; (void)wn; (void)f; (void)hi; (void)gtid; (void)gthreads; (void)w;
    TILE_LOOP(20) {
      int mt, nt;
      tile_map(q_, 20, xcdmap, mt, nt);
      const int m0 = mt * 128;
      f32x16 acc[2][2];
      zero_acc<2>(acc);
      mma_block<2>(H + (size_t)m0 * DM, DM, Wb + W_IN + (size_t)nt * 128 * 1024, 1024, 1024, acc, smem);
      const int seg = nt * 2 + wn;
      int kind, hh = 0;
      bf16_t* dst = nullptr;
      if (seg < 8) { kind = 0; dst = AQ; hh = seg; }
      else if (seg < 20) {
        const int a = (seg - 8) >> 1;
        hh = (seg - 8) & 1;
        dst = AKC + (size_t)a * (2 * MiB);
        kind = (a == 0 || a == 2 || a == 4) ? 1 : (a == 1 ? 2 : 3);
      }
      else if (seg < 28) { kind = 0; dst = BQ; hh = seg - 20; }
      else if (seg < 30) { kind = 1; dst = BK; hh = seg - 28; }
      else if (seg < 32) { kind = 3; dst = BVT; hh = seg - 30; }
      else if (seg < 36) { kind = 4; dst = CQ + (seg - 32) * 64; }
      else if (seg < 40) { kind = 4; dst = CKV + (seg - 36) * 64; }
      else if (seg == 40) kind = 5;
      else kind = 6;
#pragma unroll
      for (int mi = 0; mi < 2; ++mi) {
#pragma unroll
        for (int i4 = 0; i4 < 4; ++i4) {
          const int tb = m0 + wm * 64 + mi * 32 + 8 * i4 + 4 * hi;
          const int b = tb >> 13, s0 = tb & 8191;
          if (kind == 3) {
            uint2 o0, o1;
            o0.x = pack2(acc[mi][0][4 * i4], acc[mi][0][4 * i4 + 1]);
            o0.y = pack2(acc[mi][0][4 * i4 + 2], acc[mi][0][4 * i4 + 3]);
            o1.x = pack2(acc[mi][1][4 * i4], acc[mi][1][4 * i4 + 1]);
            o1.y = pack2(acc[mi][1][4 * i4 + 2], acc[mi][1][4 * i4 + 3]);
            *(uint2*)(dst + ((size_t)(b * 2 + hh) * 64 + f) * S_ + s0) = o0;
            *(uint2*)(dst + ((size_t)(b * 2 + hh) * 64 + f + 32) * S_ + s0) = o1;
          } else if (kind != 6) {
#pragma unroll
            for (int e = 0; e < 4; ++e) {
              const int t = tb + e, s = s0 + e;
              const float v0 = acc[mi][0][4 * i4 + e], v1 = acc[mi][1][4 * i4 + e];
              if (kind <= 1) {
                const float c = COS64[t * 32 + f], sn = SIN64[t * 32 + f];
                const float r0 = v0 * c - v1 * sn, r1 = v1 * c + v0 * sn;
                const size_t idx = kind == 0 ? ((size_t)t * 8 + hh) * 64 + f : ((size_t)(b * 2 + hh) * S_ + s) * 64 + f;
                dst[idx] = f2bf(r0);
                dst[idx + 32] = f2bf(r1);
              } else if (kind == 2) {
                const size_t idx = ((size_t)(b * 2 + hh) * S_ + s) * 64 + f;
                dst[idx] = f2bf(v0);
                dst[idx + 32] = f2bf(v1);
              } else if (kind == 4) {
                dst[(size_t)t * 256 + f] = f2bf(v0);
                dst[(size_t)t * 256 + f + 32] = f2bf(v1);
              } else {
                const float c = COS32[t * 16 + (f & 15)], sn = SIN32[t * 16 + (f & 15)];
                const float pr = __shfl_xor(v0, 16);
                const float r = (f < 16) ? v0 * c - pr * sn : v0 * c + pr * sn;
                const bf16_t rb = f2bf(r);
#pragma unroll
                for (int h = 0; h < 8; ++h) CK[((size_t)(b * 8 + h) * S_ + s) * 96 + 64 + f] = rb;
                if (f < 24) AG[(size_t)t * 24 + f] = sigmoidf_(v1);
              }
            }
          }
        }
      }
    }
    }
    xcd_barrier(xb);
    {
      char* ws = launder(ws0);
      DECL_PTRS
      const int tid = lv(threadIdx.x), lane = tid & 63, w = tid >> 6, wm = w >> 1, wn = w & 1, f = lane & 31, hi = lane >> 5;
      const int gtid = blockIdx.x * 256 + tid, gthreads = ls(G) * 256;
      (void)wm; (void)wn; (void)f; (void)hi; (void)gtid; (void)gthreads; (void)w;
    for (int tix = vbid - 64; tix < 128; tix += G) {
      if (tix < 0) continue;
      const int m0 = tix * 128;
      f32x16 acc[2][1];
      zero_acc<1>(acc);
      mma_block<1>(H + (size_t)m0 * DM, DM, Wb + W_IN + (size_t)2560 * 1024, 1024, 1024, acc, smem);
#pragma unroll
      for (int mi = 0; mi < 2; ++mi)
#pragma unroll
        for (int i = 0; i < 16; ++i) {
          const int t = m0 + wm * 64 + mi * 32 + (i & 3) + 8 * (i >> 2) + 4 * hi;
          const int b = t >> 13, sx = t & 8191;
          const float v0 = acc[mi][0][i];
          if (wn == 0) {
            const float c = COS32[t * 16 + (f & 15)], sn = SIN32[t * 16 + (f & 15)];
            const float pr = __shfl_xor(v0, 16);
            const float r = (f < 16) ? v0 * c - pr * sn : v0 * c + pr * sn;
            const bf16_t rb = f2bf(r);
#pragma unroll
            for (int h = 0; h < 8; ++h) CK[((size_t)(b * 8 + h) * S_ + sx) * 96 + 64 + f] = rb;
          } else if (f < 24) {
            AG[(size_t)t * 24 + f] = sigmoidf_(v0);
          }
        }
    }
    for (int tix = vbid; tix < 64; tix += G) {
      const int which = tix >> 5, mt = (tix >> 1) & 15, nt = tix & 1;
      f32x16 acc[2][2];
      zero_acc<2>(acc);
      mma_block<2>(AKC + (size_t)which * (2 * MiB) + (size_t)mt * 128 * 1024, 1024,
                   Wb + (which ? W_1V : W_1K) + (size_t)nt * 128 * 2048, 2048, 2048, acc, smem);
#pragma unroll
      for (int mi = 0; mi < 2; ++mi)
#pragma unroll
        for (int ni = 0; ni < 2; ++ni)
#pragma unroll
          for (int i = 0; i < 16; ++i) {
            const int row = mt * 128 + wm * 64 + mi * 32 + (i & 3) + 8 * (i >> 2) + 4 * hi;
            const int col = nt * 128 + wn * 64 + ni * 32 + f;
            const float x = acc[mi][ni][i] + BIAS[which * 256 + col];
            const float y = 0.5f * x * (1.f + tanhf(0.7978845608028654f * (x + 0.044715f * x * x * x)));
            HID[(size_t)which * 2048 * 256 + (size_t)row * 256 + col] = f2bf(y);
          }
    }
    for (int r = blockIdx.x * 4 + w; r < 2 * T_; r += G * 4) {
      const int which = r >= T_;
      const int row = which ? r - T_ : r;
      bf16_t* p = (which ? CKV : CQ) + (size_t)row * 256 + lane * 4;
      const float* gain = gptr(P.in[which ? 14 : 12]) + layer * 256 + lane * 4;
      const uint2 v = *(const uint2*)p;
      const float a0 = bflo(v.x), a1 = bfhi(v.x), a2 = bflo(v.y), a3 = bfhi(v.y);
      const float ss = wave_sum(a0 * a0 + a1 * a1 + a2 * a2 + a3 * a3);
      const float rs = rsqrtf(ss * (1.f / 256.f) + 1e-6f);
      uint2 o;
      o.x = pack2(a0 * rs * gain[0], a1 * rs * gain[1]);
      o.y = pack2(a2 * rs * gain[2], a3 * rs * gain[3]);
      *(uint2*)p = o;
    }
    }
    xcd_barrier(xb);
    {
      char* ws = launder(ws0);
      DECL_PTRS
      const int tid = lv(threadIdx.x), lane = tid & 63, w = tid >> 6, wm = w >> 1, wn = w & 1, f = lane & 31, hi = lane >> 5;
      const int gtid = blockIdx.x * 256 + tid, gthreads = ls(G) * 256;
      (void)wm; (void)wn; (void)f; (void)hi; (void)gtid; (void)gthreads; (void)w;
    for (int tix = vbid; tix < 768 + 1024 + 32; tix += G) {
      f32x16 acc[2][2];
      zero_acc<2>(acc);
      if (tix < 768) {
        const int mt = tix / 6, nt = tix % 6, m0 = mt * 128;
        mma_block<2>(CQ + (size_t)m0 * 256, 256, Wb + W_QUP + (size_t)nt * 128 * 256, 256, 256, acc, smem);
        const int seg = nt * 2 + wn;
#pragma unroll
        for (int mi = 0; mi < 2; ++mi)
#pragma unroll
          for (int i = 0; i < 16; ++i) {
            const int t = m0 + wm * 64 + mi * 32 + (i & 3) + 8 * (i >> 2) + 4 * hi;
            if (seg < 8) {
              bf16_t* d = CQF + ((size_t)t * 8 + seg) * 96 + f;
              d[0] = f2bf(acc[mi][0][i]);
              d[32] = f2bf(acc[mi][1][i]);
            } else {
              const float c = COS32[t * 16 + (f & 15)], sn = SIN32[t * 16 + (f & 15)];
#pragma unroll
              for (int ni = 0; ni < 2; ++ni) {
                const float v0 = acc[mi][ni][i];
                const float pr = __shfl_xor(v0, 16);
                const float r = (f < 16) ? v0 * c - pr * sn : v0 * c + pr * sn;
                CQF[((size_t)t * 8 + (seg - 8) * 2 + ni) * 96 + 64 + f] = f2bf(r);
              }
            }
          }
      } else if (tix < 768 + 1024) {
        const int u = tix - 768, mt = u >> 3, nt = u & 7, m0 = mt * 128;
        mma_block<2>(CKV + (size_t)m0 * 256, 256, Wb + W_KVUP + (size_t)nt * 128 * 256, 256, 256, acc, smem);
        const int seg = nt * 2 + wn;
#pragma unroll
        for (int mi = 0; mi < 2; ++mi)
#pragma unroll
          for (int i4 = 0; i4 < 4; ++i4) {
            const int tb = m0 + wm * 64 + mi * 32 + 8 * i4 + 4 * hi;
            const int b = tb >> 13, s0 = tb & 8191;
            if (seg < 8) {
#pragma unroll
              for (int e = 0; e < 4; ++e) {
                bf16_t* d = CK + ((size_t)(b * 8 + seg) * S_ + s0 + e) * 96 + f;
                d[0] = f2bf(acc[mi][0][4 * i4 + e]);
                d[32] = f2bf(acc[mi][1][4 * i4 + e]);
              }
            } else {
              uint2 o0, o1;
              o0.x = pack2(acc[mi][0][4 * i4], acc[mi][0][4 * i4 + 1]);
              o0.y = pack2(acc[mi][0][4 * i4 + 2], acc[mi][0][4 * i4 + 3]);
              o1.x = pack2(acc[mi][1][4 * i4], acc[mi][1][4 * i4 + 1]);
              o1.y = pack2(acc[mi][1][4 * i4 + 2], acc[mi][1][4 * i4 + 3]);
              *(uint2*)(CVT + ((size_t)(b * 8 + seg - 8) * 64 + f) * S_ + s0) = o0;
              *(uint2*)(CVT + ((size_t)(b * 8 + seg - 8) * 64 + f + 32) * S_ + s0) = o1;
            }
          }
      } else {
        const int u = tix - 1792, which = u >> 4, mt = u & 15;
        mma_block<2>(HID + (size_t)which * 2048 * 256 + (size_t)mt * 128 * 256, 256, Wb + (which ? W_2V : W_2K), 256, 256,
                     acc, smem);
        if (wn == 0) {
#pragma unroll
          for (int mi = 0; mi < 2; ++mi)
#pragma unroll
            for (int i4 = 0; i4 < 4; ++i4) {
              const int rb = mt * 128 + wm * 64 + mi * 32 + 8 * i4 + 4 * hi;
              if (which == 0) {
#pragma unroll
                for (int e = 0; e < 4; ++e) {
                  KCMP[(size_t)(rb + e) * 64 + f] = f2bf(acc[mi][0][4 * i4 + e]);
                  KCMP[(size_t)(rb + e) * 64 + f + 32] = f2bf(acc[mi][1][4 * i4 + e]);
                }
              } else {
                const int bg = rb >> 9, n0 = rb & 511;
                uint2 o0, o1;
                o0.x = pack2(acc[mi][0][4 * i4], acc[mi][0][4 * i4 + 1]);
                o0.y = pack2(acc[mi][0][4 * i4 + 2], acc[mi][0][4 * i4 + 3]);
                o1.x = pack2(acc[mi][1][4 * i4], acc[mi][1][4 * i4 + 1]);
                o1.y = pack2(acc[mi][1][4 * i4 + 2], acc[mi][1][4 * i4 + 3]);
                *(uint2*)(VCMPT + ((size_t)bg * 64 + f) * 512 + n0) = o0;
                *(uint2*)(VCMPT + ((size_t)bg * 64 + f + 32) * 512 + n0) = o1;
              }
            }
        }
      }
    }
    }
    xcd_barrier(xb);
    {
      char* ws = launder(ws0);
      DECL_PTRS
      const int tid = lv(threadIdx.x), lane = tid & 63, w = tid >> 6, wm = w >> 1, wn = w & 1, f = lane & 31, hi = lane >> 5;
      const int gtid = blockIdx.x * 256 + tid, gthreads = ls(G) * 256;
      (void)wm; (void)wn; (void)f; (void)hi; (void)gtid; (void)gthreads; (void)w;
    for (int it = blockIdx.x; it < 3072; it += G) {
      if (it < 1024) {
        const int bh = it & 15;
        const int qb = it < 512 ? 63 - (it >> 4) : ((it - 512) >> 4);
        mla_item(P, ws, bh >> 3, bh & 7, qb, smem);
      } else if (it < 2048) {
        const int u = it - 1024, bg = u & 3;
        const int ch = u < 512 ? 255 - (u >> 2) : ((u - 512) >> 2);
        nsa_item(P, ws, bg >> 1, bg & 1, ch, smem);
      } else {
        const int u = it - 2048, bg = u & 3;
        swa_item(P, ws, layer, bg >> 1, bg & 1, u >> 2, smem);
      }
    }
    }
    xcd_barrier(xb);
    {
      char* ws = launder(ws0);
      DECL_PTRS
      const int tid = lv(threadIdx.x), lane = tid & 63, w = tid >> 6, wm = w >> 1, wn = w & 1, f = lane & 31, hi = lane >> 5;
      const int gtid = blockIdx.x * 256 + tid, gthreads = ls(G) * 256;
      (void)wm; (void)wn; (void)f; (void)hi; (void)gtid; (void)gthreads; (void)w;
    TILE_LOOP(8) {
      int mt, nt;
      tile_map(q_, 8, xcdmap, mt, nt);
      const int m0 = mt * 128, n0 = nt * 128;
      uint32_t mpk[2][2][8];
#pragma unroll
      for (int mi = 0; mi < 2; ++mi)
#pragma unroll
        for (int ni = 0; ni < 2; ++ni)
#pragma unroll
          for (int i = 0; i < 8; ++i) mpk[mi][ni][i] = 0u;
#pragma unroll 1
      for (int br = 0; br < 3; ++br) {
        const bf16_t* Ob = br == 0 ? AQ : (br == 1 ? BQ : CQ);
        f32x16 acc[2][2];
        zero_acc<2>(acc);
        mma_block<2, true>(Ob + (size_t)m0 * 512, 512, Wb + W_PA + (size_t)br * 1024 * 512 + (size_t)n0 * 512, 512, 512, acc, smem);
        uint32_t pk[2][2][8];
#pragma unroll
        for (int mi = 0; mi < 2; ++mi)
#pragma unroll
          for (int ni = 0; ni < 2; ++ni)
#pragma unroll
            for (int i = 0; i < 8; ++i) pk[mi][ni][i] = pack2(acc[mi][ni][2 * i], acc[mi][ni][2 * i + 1]);
        zero_acc<2>(acc);
        mma_block<2, true>(H + (size_t)m0 * DM, DM, Wb + W_G + ((size_t)br * 1024 + n0) * 1024, 1024, 1024, acc, smem);
#pragma unroll
        for (int mi = 0; mi < 2; ++mi)
#pragma unroll
          for (int ni = 0; ni < 2; ++ni)
#pragma unroll
            for (int i = 0; i < 8; ++i) {
              const float a0 = bflo(mpk[mi][ni][i]) + sigmoidf_(acc[mi][ni][2 * i]) * bflo(pk[mi][ni][i]);
              const float a1 = bfhi(mpk[mi][ni][i]) + sigmoidf_(acc[mi][ni][2 * i + 1]) * bfhi(pk[mi][ni][i]);
              mpk[mi][ni][i] = pack2(a0, a1);
            }
      }
#pragma unroll
      for (int mi = 0; mi < 2; ++mi)
#pragma unroll
        for (int ni = 0; ni < 2; ++ni)
#pragma unroll
          for (int i = 0; i < 8; ++i) {
            const int t = m0 + wm * 64 + mi * 32 + ((2 * i) & 3) + 8 * ((2 * i) >> 2) + 4 * hi;
            bf16_t* mp = MERGED + (size_t)t * DM + n0 + wn * 64 + ni * 32 + f;
            mp[0] = (bf16_t)(mpk[mi][ni][i] & 0xffffu);
            mp[DM] = (bf16_t)(mpk[mi][ni][i] >> 16);
          }
    }
    }
    xcd_barrier(xb);
    {
      char* ws = launder(ws0);
      DECL_PTRS
      const int tid = lv(threadIdx.x), lane = tid & 63, w = tid >> 6, wm = w >> 1, wn = w & 1, f = lane & 31, hi = lane >> 5;
      const int gtid = blockIdx.x * 256 + tid, gthreads = ls(G) * 256;
      (void)wm; (void)wn; (void)f; (void)hi; (void)gtid; (void)gthreads; (void)w;
    TILE_LOOP(8) {
      int mt, nt;
      tile_map(q_, 8, xcdmap, mt, nt);
      const int m0 = mt * 128, n0 = nt * 128;
      f32x16 acc[2][2];
      zero_acc<2>(acc);
      mma_block<2>(MERGED + (size_t)m0 * DM, DM, Wb + W_OUT + (size_t)n0 * 1024, 1024, 1024, acc, smem);
#pragma unroll
      for (int mi = 0; mi < 2; ++mi)
#pragma unroll
        for (int ni = 0; ni < 2; ++ni)
#pragma unroll
          for (int i = 0; i < 16; ++i) {
            const size_t idx = (size_t)(m0 + wm * 64 + mi * 32 + (i & 3) + 8 * (i >> 2) + 4 * hi) * DM + n0 + wn * 64 + ni * 32 + f;
            xo[idx] = xi[idx] + acc[mi][ni][i];
            if ((i & 15) == 15) asm volatile("" ::: "memory");
          }
    }
    }
    xcd_barrier(xb);
    {
      char* ws = launder(ws0);
      DECL_PTRS
      const int tid = lv(threadIdx.x), lane = tid & 63, w = tid >> 6, wm = w >> 1, wn = w & 1, f = lane & 31, hi = lane >> 5;
      const int gtid = blockIdx.x * 256 + tid, gthreads = ls(G) * 256;
      (void)wm; (void)wn; (void)f; (void)hi; (void)gtid; (void)gthreads; (void)w;
    norm_rows_f32(xo, gptr(P.in[21]) + layer * DM, H);
    }
    xcd_barrier(xb);
    {
      char* ws = launder(ws0);
      DECL_PTRS
      const int tid = lv(threadIdx.x), lane = tid & 63, w = tid >> 6, wm = w >> 1, wn = w & 1, f = lane & 31, hi = lane >> 5;
      const int gtid = blockIdx.x * 256 + tid, gthreads = ls(G) * 256;
      (void)wm; (void)wn; (void)f; (void)hi; (void)gtid; (void)gthreads; (void)w;
    TILE_LOOP(44) {
      int mt, nt;
      tile_map(q_, 44, xcdmap, mt, nt);
      const int m0 = mt * 128;
      f32x16 acc[2][2];
      zero_acc<2>(acc);
      mma_block<2>(H + (size_t)m0 * DM, DM, Wb + W_GU + (size_t)nt * 128 * 1024, 1024, 1024, acc, smem);
      const int cb = (nt * 2 + wn) * 32 + f;
#pragma unroll
      for (int mi = 0; mi < 2; ++mi)
#pragma unroll
        for (int i = 0; i < 16; ++i) {
          const int t = m0 + wm * 64 + mi * 32 + (i & 3) + 8 * (i >> 2) + 4 * hi;
          const float gte = acc[mi][0][i], up = acc[mi][1][i];
          ACT[(size_t)t * DFF + cb] = f2bf(gte * sigmoidf_(gte) * up);
        }
    }
    }
    xcd_barrier(xb);
    {
      char* ws = launder(ws0);
      DECL_PTRS
      const int tid = lv(threadIdx.x), lane = tid & 63, w = tid >> 6, wm = w >> 1, wn = w & 1, f = lane & 31, hi = lane >> 5;
      const int gtid = blockIdx.x * 256 + tid, gthreads = ls(G) * 256;
      (void)wm; (void)wn; (void)f; (void)hi; (void)gtid; (void)gthreads; (void)w;
    TILE_LOOP(8) {
      int mt, nt;
      tile_map(q_, 8, xcdmap, mt, nt);
      const int m0 = mt * 128, n0 = nt * 128;
      f32x16 acc[2][2];
      zero_acc<2>(acc);
      mma_block<2>(ACT + (size_t)m0 * DFF, DFF, Wb + W_DOWN + (size_t)n0 * DFF, DFF, DFF, acc, smem);
#pragma unroll
      for (int mi = 0; mi < 2; ++mi)
#pragma unroll
        for (int ni = 0; ni < 2; ++ni)
#pragma unroll
          for (int i = 0; i < 16; ++i) {
            const size_t idx = (size_t)(m0 + wm * 64 + mi * 32 + (i & 3) + 8 * (i >> 2) + 4 * hi) * DM + n0 + wn * 64 + ni * 32 + f;
            xo[idx] += acc[mi][ni][i];
            if ((i & 15) == 15) asm volatile("" ::: "memory");
          }
    }
    }
    xcd_barrier(xb);
    {
      char* ws = launder(ws0);
      DECL_PTRS
      const int tid = lv(threadIdx.x), lane = tid & 63, w = tid >> 6, wm = w >> 1, wn = w & 1, f = lane & 31, hi = lane >> 5;
      const int gtid = blockIdx.x * 256 + tid, gthreads = ls(G) * 256;
      (void)wm; (void)wn; (void)f; (void)hi; (void)gtid; (void)gthreads; (void)w;
    norm_rows_f32(xo, gptr(P.in[25]) + layer * DM, H);
    }
    xcd_barrier(xb);
    {
      char* ws = launder(ws0);
      DECL_PTRS
      const int tid = lv(threadIdx.x), lane = tid & 63, w = tid >> 6, wm = w >> 1, wn = w & 1, f = lane & 31, hi = lane >> 5;
      const int gtid = blockIdx.x * 256 + tid, gthreads = ls(G) * 256;
      (void)wm; (void)wn; (void)f; (void)hi; (void)gtid; (void)gthreads; (void)w;
    TILE_LOOP(16) {
      int mt, nt;
      tile_map(q_, 16, xcdmap, mt, nt);
      const int m0 = mt * 128, n0 = nt * 64;
      f32x16 acc[2][1];
      zero_acc<1>(acc);
      mma_block<1>(PB + (size_t)m0 * 256, 256, Wb + W_PLEP + (size_t)n0 * 256, 256, 256, acc, smem);
      uint32_t pk[2][8];
#pragma unroll
      for (int mi = 0; mi < 2; ++mi)
#pragma unroll
        for (int i = 0; i < 8; ++i) pk[mi][i] = pack2(acc[mi][0][2 * i], acc[mi][0][2 * i + 1]);
      zero_acc<1>(acc);
      mma_block<1>(H + (size_t)m0 * DM, DM, Wb + W_PLEG + (size_t)n0 * 1024, 1024, 1024, acc, smem);
#pragma unroll
      for (int mi = 0; mi < 2; ++mi)
#pragma unroll
        for (int i = 0; i < 16; ++i) {
          const size_t idx = (size_t)(m0 + wm * 64 + mi * 32 + (i & 3) + 8 * (i >> 2) + 4 * hi) * DM + n0 + wn * 32 + f;
          const uint32_t pv = pk[mi][i >> 1];
          const float pj = (i & 1) ? bfhi(pv) : bflo(pv);
          xo[idx] += sigmoidf_(acc[mi][0][i]) * pj;
          if ((i & 15) == 15) asm volatile("" ::: "memory");
        }
    }
    }
    xcd_barrier(xb);
  }
  {
    const float* gain = gptr(P.in[28]);
    const int tid = lv(threadIdx.x), lane = tid & 63, w = tid >> 6;
    for (int row = blockIdx.x * 4 + w; row < T_; row += G * 4) {
      float* xp = xo + (size_t)row * DM;
      float4 v[4];
      float ss = 0.f;
#pragma unroll
      for (int i = 0; i < 4; ++i) {
        v[i] = *(const float4*)(xp + i * 256 + lane * 4);
        ss += v[i].x * v[i].x + v[i].y * v[i].y + v[i].z * v[i].z + v[i].w * v[i].w;
      }
      ss = wave_sum(ss);
      const float rs = rsqrtf(ss * (1.f / DM) + 1e-6f);
#pragma unroll
      for (int i = 0; i < 4; ++i) {
        const float4 g = *(const float4*)(gain + i * 256 + lane * 4);
        float4 o;
        o.x = v[i].x * rs * g.x; o.y = v[i].y * rs * g.y; o.z = v[i].z * rs * g.z; o.w = v[i].w * rs * g.w;
        *(float4*)(xp + i * 256 + lane * 4) = o;
      }
    }
  }
}

extern "C" void kernel_launch(void* const* d_in, const int* in_sizes, int n_in, void* d_out, int out_size, void* d_ws,
                              size_t ws_size, hipStream_t stream) {
  static int grid_blocks = 0;
  if (!grid_blocks) {
    int dev = 0, cus = 0, per_cu = 0;
    hipGetDevice(&dev);
    hipDeviceGetAttribute(&cus, hipDeviceAttributeMultiprocessorCount, dev);
    hipOccupancyMaxActiveBlocksPerMultiprocessor(&per_cu, mega, 256, 0);
    if (per_cu > 2) per_cu = 2;
    if (per_cu < 1) per_cu = 1;
    grid_blocks = cus * per_cu;
  }
  if (ws_size < WS_NEED) {
    fprintf(stderr, "workspace too small: %zu < %zu\n", ws_size, (size_t)WS_NEED);
    return;
  }
  hipMemsetAsync((char*)d_ws + OFF_BAR, 0, XCD_BAR_WORDS * sizeof(unsigned), stream);
  Params p{};
  for (int i = 0; i < 29; ++i) p.in[i] = (const float*)d_in[i];
  p.out = (float*)d_out;
  p.ws = (char*)d_ws;
  void* args[] = {&p};
  hipError_t e = hipLaunchCooperativeKernel((void*)mega, dim3(grid_blocks), dim3(256), args, 0, stream);
  if (e != hipSuccess) fprintf(stderr, "cooperative launch failed: %s (grid %d)\n", hipGetErrorString(e), grid_blocks);
}
```

```cpp
#include <hip/hip_runtime.h>
#include <hip/hip_cooperative_groups.h>
#include <stdint.h>
#include <stdio.h>
namespace cg = cooperative_groups;

typedef unsigned short bf16_t;
typedef __attribute__((ext_vector_type(8))) short bf16x8;
typedef __attribute__((ext_vector_type(4))) float f32x4;
typedef __attribute__((ext_vector_type(16))) float f32x16;
typedef __attribute__((ext_vector_type(4))) unsigned u32x4;
#define DI __device__ __forceinline__
#define GAS __attribute__((address_space(1)))
DI char* launder(char* p) {
  unsigned long long v = (unsigned long long)p;
  asm volatile("" : "+s"(v));
  return (char*)(GAS char*)v;
}
template <class T>
DI T* gptr(T* p) {
  return (T*)(GAS T*)(unsigned long long)p;
}

constexpr int S_ = 8192, T_ = 16384, DM = 1024, DFF = 2816;
constexpr size_t MiB = 1ull << 20;
constexpr size_t OFF_W = 0, OFF_H = 40 * MiB, OFF_Z = 72 * MiB, OFF_M = 154 * MiB, OFF_X = 218 * MiB;
constexpr size_t OFF_BAR = 240 * MiB;
constexpr size_t WS_NEED = 241 * MiB;
constexpr size_t W_IN = 0;
constexpr size_t W_1K = W_IN + 2688ull * 1024;
constexpr size_t W_1V = W_1K + 256ull * 2048;
constexpr size_t W_2K = W_1V + 256ull * 2048;
constexpr size_t W_2V = W_2K + 128ull * 256;
constexpr size_t W_QUP = W_2V + 128ull * 256;
constexpr size_t W_KVUP = W_QUP + 768ull * 256;
constexpr size_t W_G = W_KVUP + 1024ull * 256;
constexpr size_t W_PA = W_G + 3072ull * 1024;
constexpr size_t W_PB = W_PA + 1024ull * 512;
constexpr size_t W_PC = W_PB + 1024ull * 512;
constexpr size_t W_OUT = W_PC + 1024ull * 512;
constexpr size_t W_GU = W_OUT + 1024ull * 1024;
constexpr size_t W_DOWN = W_GU + 5632ull * 1024;
constexpr size_t W_PLEP = W_DOWN + 1024ull * 2816;
constexpr size_t W_PLEG = W_PLEP + 1024ull * 256;
constexpr size_t W_END = W_PLEG + 1024ull * 1024;
static_assert(W_END * 2 <= 40 * MiB, "weights region");

constexpr float LOG2E = 1.4426950408889634f;
constexpr int SMEM_BYTES = 73728;
constexpr int L_KB = 0, L_VB = 13312, L_IMP = 22528, L_VALS = L_IMP + 2 * 32 * 132 * 4, L_SELM = L_VALS + 32 * 128 * 4, L_UNI = L_SELM + 512;
static_assert(L_UNI + 16 <= SMEM_BYTES, "lds");

struct Params {
  const float* in[29];
  float* out;
  char* ws;
};

typedef __attribute__((ext_vector_type(2))) __bf16 bf2_t;
typedef __attribute__((ext_vector_type(2))) float f2_t;
DI uint32_t pack2(float a, float b) {
  f2_t v = {a, b};
  return __builtin_bit_cast(uint32_t, __builtin_convertvector(v, bf2_t));
}
DI bf16_t f2bf(float x) { return (bf16_t)(pack2(x, 0.f) & 0xffffu); }
DI float bflo(uint32_t v) { return __uint_as_float(v << 16); }
DI float bfhi(uint32_t v) { return __uint_as_float(v & 0xffff0000u); }
DI float sigmoidf_(float x) { return 1.f / (1.f + __expf(-x)); }
DI int lv(int x) {
  asm volatile("" : "+v"(x));
  return x;
}
DI int ls(int x) {
  asm volatile("" : "+s"(x));
  return x;
}
DI float lz0() {
  float z = 0.f;
  asm volatile("" : "+v"(z));
  return z;
}
DI float x16(float v) {
  auto r = __builtin_amdgcn_permlane16_swap(__float_as_uint(v), __float_as_uint(v), false, false);
  return __uint_as_float(((threadIdx.x >> 4) & 1) ? r[0] : r[1]);
}
DI float x32(float v) {
  auto r = __builtin_amdgcn_permlane32_swap(__float_as_uint(v), __float_as_uint(v), false, false);
  return __uint_as_float(((threadIdx.x >> 5) & 1) ? r[0] : r[1]);
}
DI float max16_32(float v) {
  auto r = __builtin_amdgcn_permlane16_swap(__float_as_uint(v), __float_as_uint(v), false, false);
  v = fmaxf(__uint_as_float(r[0]), __uint_as_float(r[1]));
  auto q = __builtin_amdgcn_permlane32_swap(__float_as_uint(v), __float_as_uint(v), false, false);
  return fmaxf(__uint_as_float(q[0]), __uint_as_float(q[1]));
}
DI float sum16_32(float v) {
  auto r = __builtin_amdgcn_permlane16_swap(__float_as_uint(v), __float_as_uint(v), false, false);
  v = __uint_as_float(r[0]) + __uint_as_float(r[1]);
  auto q = __builtin_amdgcn_permlane32_swap(__float_as_uint(v), __float_as_uint(v), false, false);
  return __uint_as_float(q[0]) + __uint_as_float(q[1]);
}
DI float wave_sum(float v) {
  for (int o = 32; o > 0; o >>= 1) v += __shfl_xor(v, o);
  return v;
}


__device__ const float INVF64[32] = {1.f, 0.749894261f, 0.562341332f, 0.421696514f, 0.316227764f, 0.237137377f, 0.177827939f, 0.133352131f,
    0.100000001f, 0.0749894157f, 0.0562341325f, 0.0421696529f, 0.0316227749f, 0.0237137377f, 0.0177827943f, 0.0133352149f,
    0.00999999978f, 0.00749894185f, 0.00562341325f, 0.00421696482f, 0.00316227763f, 0.00237137359f, 0.00177827943f, 0.00133352145f,
    0.00100000005f, 0.000749894243f, 0.000562341302f, 0.000421696517f, 0.000316227757f, 0.00023713737f, 0.00017782794f, 0.00013335215f};
DI void sincos_acc(float ang, float& c, float& s) {
  const double x = (double)ang;
  const double kd = rint(x * 0.6366197723675814);
  double r = fma(-kd, 1.5707963267948966, x);
  r = fma(-kd, 6.123233995736766e-17, r);
  const int k = (int)kd;
  const double r2 = r * r;
  const double sp = r * (1.0 + r2 * (-1.0 / 6 + r2 * (1.0 / 120 + r2 * (-1.0 / 5040 + r2 * (1.0 / 362880 + r2 * (-1.0 / 39916800 + r2 * (1.0 / 6227020800.0)))))));
  const double cp = 1.0 + r2 * (-0.5 + r2 * (1.0 / 24 + r2 * (-1.0 / 720 + r2 * (1.0 / 40320 + r2 * (-1.0 / 3628800 + r2 * (1.0 / 479001600.0))))));
  const int qd = k & 3;
  const double sv = (qd == 0) ? sp : (qd == 1) ? cp : (qd == 2) ? -sp : -cp;
  const double cv = (qd == 0) ? cp : (qd == 1) ? -sp : (qd == 2) ? -cp : sp;
  s = (float)sv;
  c = (float)cv;
}

template <int NT, bool LEAN = false>
DI void mma_block(const bf16_t* __restrict__ A, int lda, const bf16_t* __restrict__ B, int ldb, int K,
                  f32x16 (&acc)[2][NT], char* smem) {
  constexpr int ASZ = 128 * 144, BSZ = 64 * NT * 144;
  char* As = smem;
  char* Bs = smem + 2 * ASZ;
  const int tid = lv(threadIdx.x), lane = tid & 63, w = tid >> 6, wm = w >> 1, wn = w & 1;
  const int crow = tid >> 3, ccol = tid & 7;
  u32x4 ra0[4], rb0[2 * NT], ra1[4], rb1[2 * NT];
  const unsigned aoff = (unsigned)(crow * lda + ccol * 8) * 2u, astep = (unsigned)lda * 64u;
  const unsigned boff = (unsigned)(crow * ldb + ccol * 8) * 2u, bstep = (unsigned)ldb * 64u;
  const char* Ac = (const char*)A;
  const char* Bc = (const char*)B;
  const int nk = K >> 6;
  const int soff = crow * 144 + ccol * 16;
#define MMA_GLOAD(ra, rb, k0)                                                                        \
  {                                                                                                  \
    _Pragma("unroll") for (int i = 0; i < 4; ++i) ra[i] = *(const u32x4*)(Ac + (size_t)(k0) * 2 + (aoff + i * astep)); \
    _Pragma("unroll") for (int i = 0; i < 2 * NT; ++i) rb[i] = *(const u32x4*)(Bc + (size_t)(k0) * 2 + (boff + i * bstep)); \
  }
#define MMA_SSTORE(ra, rb, buf)                                                                      \
  {                                                                                                  \
    _Pragma("unroll") for (int i = 0; i < 4; ++i) *(u32x4*)(As + (buf) * ASZ + soff + 32 * i * 144) = ra[i]; \
    _Pragma("unroll") for (int i = 0; i < 2 * NT; ++i) *(u32x4*)(Bs + (buf) * BSZ + soff + 32 * i * 144) = rb[i]; \
  }
#define MMA_RDFRAG(buf, ks, fa, fb)                                                                  \
  {                                                                                                  \
    _Pragma("unroll") for (int mi = 0; mi < 2; ++mi) fa[mi] = *(const bf16x8*)(As + (buf) * ASZ + arow + mi * 32 * 144 + (ks) * 32); \
    _Pragma("unroll") for (int ni = 0; ni < NT; ++ni) fb[ni] = *(const bf16x8*)(Bs + (buf) * BSZ + brow + ni * 32 * 144 + (ks) * 32); \
  }
#define MMA_DO(fa, fb)                                                                               \
  {                                                                                                  \
    _Pragma("unroll") for (int mi = 0; mi < 2; ++mi)                                                 \
      _Pragma("unroll") for (int ni = 0; ni < NT; ++ni)                                              \
        acc[mi][ni] = __builtin_amdgcn_mfma_f32_32x32x16_bf16(fa[mi], fb[ni], acc[mi][ni], 0, 0, 0); \
  }
#define MMA_SSTORE_A(ra, buf)                                                                        \
  { _Pragma("unroll") for (int i = 0; i < 4; ++i) *(u32x4*)(As + (buf) * ASZ + soff + 32 * i * 144) = ra[i]; }
#define MMA_SSTORE_B(rb, buf)                                                                        \
  { _Pragma("unroll") for (int i = 0; i < 2 * NT; ++i) *(u32x4*)(Bs + (buf) * BSZ + soff + 32 * i * 144) = rb[i]; }
#define MMA_STEP(buf, sra, srb, dostore, lra, lrb, doload, lk0)                                      \
  {                                                                                                  \
    bf16x8 fa0[2], fb0[NT], fa1[2], fb1[NT];                                                         \
    MMA_RDFRAG(buf, 0, fa0, fb0);                                                                    \
    MMA_RDFRAG(buf, 1, fa1, fb1);                                                                    \
    MMA_DO(fa0, fb0);                                                                                \
    if (doload) MMA_GLOAD(lra, lrb, lk0);                                                            \
    MMA_RDFRAG(buf, 2, fa0, fb0);                                                                    \
    if (dostore) MMA_SSTORE_A(sra, (buf) ^ 1);                                                       \
    MMA_DO(fa1, fb1);                                                                                \
    MMA_RDFRAG(buf, 3, fa1, fb1);                                                                    \
    if (dostore) MMA_SSTORE_B(srb, (buf) ^ 1);                                                       \
    MMA_DO(fa0, fb0);                                                                                \
    MMA_DO(fa1, fb1);                                                                                \
    __builtin_amdgcn_sched_group_barrier(0x100, 2 * (2 + NT), 0);                                    \
    __builtin_amdgcn_sched_group_barrier(0x008, 2 * NT, 0);                                          \
    __builtin_amdgcn_sched_group_barrier(0x020, 4 + 2 * NT, 0);                                      \
    __builtin_amdgcn_sched_group_barrier(0x100, 2 + NT, 0);                                          \
    __builtin_amdgcn_sched_group_barrier(0x200, 4, 0);                                               \
    __builtin_amdgcn_sched_group_barrier(0x008, 2 * NT, 0);                                          \
    __builtin_amdgcn_sched_group_barrier(0x100, 2 + NT, 0);                                          \
    __builtin_amdgcn_sched_group_barrier(0x200, 2 * NT, 0);                                          \
    __builtin_amdgcn_sched_group_barrier(0x008, 2 * NT, 0);                                          \
    __builtin_amdgcn_sched_group_barrier(0x008, 2 * NT, 0);                                          \
  }
#define MMA_STEP_LEAN(buf, sra, srb, dostore, lra, lrb, doload, lk0)                                 \
  {                                                                                                  \
    bf16x8 fa0[2], fb0[NT];                                                                          \
    if (doload) MMA_GLOAD(lra, lrb, lk0);                                                            \
    MMA_RDFRAG(buf, 0, fa0, fb0);                                                                    \
    MMA_DO(fa0, fb0);                                                                                \
    MMA_RDFRAG(buf, 1, fa0, fb0);                                                                    \
    MMA_DO(fa0, fb0);                                                                                \
    if (dostore) MMA_SSTORE_A(sra, (buf) ^ 1);                                                       \
    MMA_RDFRAG(buf, 2, fa0, fb0);                                                                    \
    MMA_DO(fa0, fb0);                                                                                \
    if (dostore) MMA_SSTORE_B(srb, (buf) ^ 1);                                                       \
    MMA_RDFRAG(buf, 3, fa0, fb0);                                                                    \
    MMA_DO(fa0, fb0);                                                                                \
  }
  __syncthreads();
  MMA_GLOAD(ra0, rb0, 0);
  MMA_GLOAD(ra1, rb1, 64);
  MMA_SSTORE(ra0, rb0, 0);
  __syncthreads();
  const int arow = (wm * 64 + (lane & 31)) * 144 + (lane >> 5) * 16;
  const int brow = (wn * 32 * NT + (lane & 31)) * 144 + (lane >> 5) * 16;
  for (int kt = 0; kt < nk; kt += 2) {
    if (LEAN) { MMA_STEP_LEAN(0, ra1, rb1, true, ra0, rb0, (kt + 2 < nk), (kt + 2) << 6); }
    else { MMA_STEP(0, ra1, rb1, true, ra0, rb0, (kt + 2 < nk), (kt + 2) << 6); }
    __syncthreads();
    if (LEAN) { MMA_STEP_LEAN(1, ra0, rb0, (kt + 2 < nk), ra1, rb1, (kt + 3 < nk), (kt + 3) << 6); }
    else { MMA_STEP(1, ra0, rb0, (kt + 2 < nk), ra1, rb1, (kt + 3 < nk), (kt + 3) << 6); }
    __syncthreads();
  }
#undef MMA_RDFRAG
#undef MMA_DO
#undef MMA_SSTORE_A
#undef MMA_SSTORE_B
#undef MMA_STEP
#undef MMA_STEP_LEAN
#undef MMA_GLOAD
#undef MMA_SSTORE
#undef MMA_COMPUTE
}

template <int NT>
DI void zero_acc(f32x16 (&acc)[2][NT]) {
  const float z_ = lz0();
#pragma unroll
  for (int mi = 0; mi < 2; ++mi)
#pragma unroll
    for (int ni = 0; ni < NT; ++ni)
#pragma unroll
      for (int i = 0; i < 16; ++i) acc[mi][ni][i] = z_;
}

template <bool FFN = false>
DI void conv_seg(const float* __restrict__ src, int ldN, int c0, int nc, int K, bf16_t* __restrict__ dst, int r0,
                 int& base, char* smem) {
  float* tile = (float*)smem;
  const int tid = lv(threadIdx.x), G = gridDim.x;
  const int nkt = K >> 6, nnt = (nc + 63) >> 6, total = nkt * nnt;
  int first = ((int)blockIdx.x - (base % G) + G) % G;
  base += total;
  const int r = tid >> 4, c4 = (tid & 15) * 4;
  f32x4 v0, v1, v2, v3;
#define CONV_PREFETCH(tt)                                                                            \
  {                                                                                                  \
    const int kt_ = (tt) % nkt, nt_ = (tt) / nkt;                                                    \
    const int n_ = nt_ * 64 + c4;                                                                    \
    const float* sp_ = src + (size_t)(kt_ * 64 + r) * ldN + c0 + n_;                                 \
    const float zz_ = lz0();                                                                         \
    const f32x4 z_ = {zz_, zz_, zz_, zz_};                                                           \
    v0 = v1 = v2 = v3 = z_;                                                                          \
    if (n_ < nc) {                                                                                   \
      v0 = *(const f32x4*)(sp_);                                                                     \
      v1 = *(const f32x4*)(sp_ + (size_t)16 * ldN);                                                  \
      v2 = *(const f32x4*)(sp_ + (size_t)32 * ldN);                                                  \
      v3 = *(const f32x4*)(sp_ + (size_t)48 * ldN);                                                  \
    }                                                                                                \
  }
  if (first < total) CONV_PREFETCH(first);
  for (int t = first; t < total; t += G) {
    const int kt = t % nkt, nt = t / nkt;
    __syncthreads();
    {
      float* tp = tile + r * 65 + c4;
      tp[0] = v0[0]; tp[1] = v0[1]; tp[2] = v0[2]; tp[3] = v0[3];
      tp += 16 * 65;
      tp[0] = v1[0]; tp[1] = v1[1]; tp[2] = v1[2]; tp[3] = v1[3];
      tp += 16 * 65;
      tp[0] = v2[0]; tp[1] = v2[1]; tp[2] = v2[2]; tp[3] = v2[3];
      tp += 16 * 65;
      tp[0] = v3[0]; tp[1] = v3[1]; tp[2] = v3[2]; tp[3] = v3[3];
    }
    if (t + G < total) CONV_PREFETCH(t + G);
    __syncthreads();
    {
      const int n = tid >> 2, kq = (tid & 3) * 16;
      if (nt * 64 + n < nc) {
        uint32_t o[8];
#pragma unroll
        for (int i = 0; i < 8; ++i) o[i] = pack2(tile[(kq + 2 * i) * 65 + n], tile[(kq + 2 * i + 1) * 65 + n]);
        const int nn = nt * 64 + n;
        const int drow = FFN ? (r0 + (nn >> 5) * 64 + (nn & 31)) : (r0 + nn);
        uint4* dp = (uint4*)(dst + (size_t)drow * K + kt * 64 + kq);
        dp[0] = make_uint4(o[0], o[1], o[2], o[3]);
        dp[1] = make_uint4(o[4], o[5], o[6], o[7]);
      }
    }
  }
}

#undef CONV_PREFETCH
DI void norm_rows_f32(const float* __restrict__ x, const float* __restrict__ gain, bf16_t* __restrict__ dst) {
  const int tid_ = lv(threadIdx.x), lane = tid_ & 63, w = tid_ >> 6;
  for (int row = blockIdx.x * 4 + w; row < T_; row += gridDim.x * 4) {
    const float* xp = x + (size_t)row * DM;
    float4 v[4];
    float ss = 0.f;
#pragma unroll
    for (int i = 0; i < 4; ++i) {
      v[i] = *(const float4*)(xp + i * 256 + lane * 4);
      ss += v[i].x * v[i].x + v[i].y * v[i].y + v[i].z * v[i].z + v[i].w * v[i].w;
    }
    ss = wave_sum(ss);
    const float rs = rsqrtf(ss * (1.f / DM) + 1e-6f);
#pragma unroll
    for (int i = 0; i < 4; ++i) {
      const float4 g = *(const float4*)(gain + i * 256 + lane * 4);
      uint2 o;
      o.x = pack2(v[i].x * rs * g.x, v[i].y * rs * g.y);
      o.y = pack2(v[i].z * rs * g.z, v[i].w * rs * g.w);
      *(uint2*)(dst + (size_t)row * DM + i * 256 + lane * 4) = o;
    }
  }
}

#define KVREGS(name, DQK) u32x4 name##k[(DQK) / 32], name##v[2]

template <int DQK, bool LOADV>
DI void kv_gload_(u32x4 (&rk)[DQK / 32], u32x4 (&rv)[2], const bf16_t* __restrict__ Kt, const bf16_t* __restrict__ Vt, int Sv) {
  const int tid = lv(threadIdx.x);
#pragma unroll
  for (int i = 0; i < DQK / 32; ++i) rk[i] = *(const u32x4*)((const char*)Kt + (size_t)(tid + 256 * i) * 16);
  if (LOADV) {
#pragma unroll
    for (int i = 0; i < 2; ++i) {
      const int c = tid + 256 * i, d = c >> 3, cc = c & 7;
      rv[i] = *(const u32x4*)(Vt + (size_t)d * Sv + cc * 8);
    }
  }
}
template <int DQK, bool LOADV>
DI void kv_sstore_(const u32x4 (&rk)[DQK / 32], const u32x4 (&rv)[2], char* smem) {
  constexpr int CPR = DQK / 8, KSTR = DQK * 2 + 16;
  const int tid = lv(threadIdx.x);
#pragma unroll
  for (int i = 0; i < DQK / 32; ++i) {
    const int c = tid + 256 * i, k = c / CPR, cc = c % CPR;
    const int rho = (k & 32) | (((k >> 2) & 1) << 4) | (((k >> 3) & 3) << 2) | (k & 3);
    *(u32x4*)(smem + L_KB + rho * KSTR + cc * 16) = rk[i];
  }
  if (LOADV) {
#pragma unroll
    for (int i = 0; i < 2; ++i) {
      const int c = tid + 256 * i, d = c >> 3, cc = c & 7;
      *(u32x4*)(smem + L_VB + d * 144 + cc * 16) = rv[i];
    }
  }
}
#define kv_gload(DQK, LV, rg, K, V, SV) kv_gload_<DQK, LV>(rg##k, rg##v, K, V, SV)
#define kv_sstore(DQK, LV, rg, sm) kv_sstore_<DQK, LV>(rg##k, rg##v, sm)

template <int NQ, int KS, int MODE, int MASKMODE>
DI void attn_tile(const char* smem, const bf16x8 (&Qf)[NQ][KS], f32x4 (&O)[NQ][4], float (&m)[NQ], float (&l)[NQ],
                  float sc2, const int (&kmax)[NQ], const int (&kmin)[NQ], float* improw, int Jbase) {
  constexpr int KSTR = KS * 64 + 16;
  const int lane = lv(threadIdx.x) & 63, q = lane & 15, g4 = lane >> 4;
  const char* Kb = smem + L_KB + q * KSTR + g4 * 16;
  const char* Vb = smem + L_VB + q * 144 + g4 * 16;
  f32x4 Sa[NQ][4];
#pragma unroll
  for (int c = 0; c < NQ; ++c)
#pragma unroll
    for (int u = 0; u < 4; ++u) Sa[c][u] = f32x4{0.f, 0.f, 0.f, 0.f};
#pragma unroll
  for (int u = 0; u < 4; ++u)
#pragma unroll
    for (int ks = 0; ks < KS; ++ks) {
      const bf16x8 a = *(const bf16x8*)(Kb + (16 * u) * KSTR + ks * 64);
#pragma unroll
      for (int c = 0; c < NQ; ++c) Sa[c][u] = __builtin_amdgcn_mfma_f32_16x16x32_bf16(a, Qf[c][ks], Sa[c][u], 0, 0, 0);
    }
  bf16x8 Pf[NQ][2];
  float ia[4] = {0.f, 0.f, 0.f, 0.f}, ib[4] = {0.f, 0.f, 0.f, 0.f};
#pragma unroll
  for (int c = 0; c < NQ; ++c) {
    float sv[16];
    const int kx = kmax[c] - 8 * g4, kn = kmin[c] - 8 * g4;
#pragma unroll
    for (int u = 0; u < 4; ++u)
#pragma unroll
      for (int i = 0; i < 4; ++i) {
        const int kc = 32 * (u >> 1) + 4 * (u & 1) + i;
        float v = Sa[c][u][i];
        if (MASKMODE >= 1) v = (kc <= kx) ? v : -1e30f;
        if (MASKMODE == 2) v = (kc >= kn) ? v : -1e30f;
        sv[4 * u + i] = v;
      }
    float p[16];
    if (MODE == 2) {
      const float msc = m[c] * sc2;
#pragma unroll
      for (int e = 0; e < 16; ++e) p[e] = __builtin_amdgcn_exp2f(fmaf(sv[e], sc2, -msc)) * l[c];
#pragma unroll
      for (int u = 0; u < 4; ++u) {
        ia[u] += p[4 * u] + p[4 * u + 1] + p[4 * u + 2] + 0.5f * p[4 * u + 3];
        ib[u] += 0.5f * p[4 * u + 3];
      }
    } else {
      float mx = sv[0];
#pragma unroll
      for (int e = 1; e < 16; ++e) mx = fmaxf(mx, sv[e]);
      if (__builtin_amdgcn_ballot_w64((mx - m[c]) * sc2 > 5.770780163555854f) != 0ull) {
        mx = max16_32(mx);
        const float mn = fmaxf(m[c], mx);
        const float alpha = __builtin_amdgcn_exp2f((m[c] - mn) * sc2);
        m[c] = mn;
        l[c] *= alpha;
        if (MODE == 0) {
#pragma unroll
          for (int dt = 0; dt < 4; ++dt) O[c][dt] *= alpha;
        }
      }
      const float msc = m[c] * sc2;
      float rs = 0.f;
#pragma unroll
      for (int e = 0; e < 16; ++e) {
        p[e] = __builtin_amdgcn_exp2f(fmaf(sv[e], sc2, -msc));
        rs += p[e];
      }
      l[c] += rs;
    }
    if (MODE != 1) {
#pragma unroll
      for (int hf = 0; hf < 2; ++hf) {
        uint32_t pk[4];
#pragma unroll
        for (int j = 0; j < 4; ++j) pk[j] = pack2(p[8 * hf + 2 * j], p[8 * hf + 2 * j + 1]);
        Pf[c][hf] = __builtin_bit_cast(bf16x8, u32x4{pk[0], pk[1], pk[2], pk[3]});
      }
    }
  }
  if (MODE == 2) {
#pragma unroll
    for (int hf = 0; hf < 2; ++hf) {
      const int J = Jbase + 8 * hf + 2 * g4;
      improw[J] += ia[2 * hf];
      improw[J + 1] += ia[2 * hf + 1];
      __builtin_amdgcn_fence(__ATOMIC_SEQ_CST, "wavefront");
      improw[J + 1] += ib[2 * hf];
      improw[J + 2] += ib[2 * hf + 1];
      __builtin_amdgcn_fence(__ATOMIC_SEQ_CST, "wavefront");
    }
  }
  if (MODE != 1) {
#pragma unroll
    for (int hf = 0; hf < 2; ++hf)
#pragma unroll
      for (int dt = 0; dt < 4; ++dt) {
        const bf16x8 a = *(const bf16x8*)(Vb + dt * 16 * 144 + hf * 64);
#pragma unroll
        for (int c = 0; c < NQ; ++c) O[c][dt] = __builtin_amdgcn_mfma_f32_16x16x32_bf16(a, Pf[c][hf], O[c][dt], 0, 0, 0);
      }
  }
}

template <int NQ>
DI void attn_finish(f32x4 (&O)[NQ][4], float (&l)[NQ]) {
#pragma unroll
  for (int c = 0; c < NQ; ++c) {
    const float t = sum16_32(l[c]);
    l[c] = t > 0.f ? 1.f / t : 0.f;
  }
}

DI void nsa_item(const Params& P, char* ws, int b, int g, int ch, char* smem) {
  bf16_t* AQ = (bf16_t*)(ws + OFF_Z);
  const bf16_t* AKS = (const bf16_t*)(ws + OFF_Z + 24 * MiB);
  const bf16_t* AVST = (const bf16_t*)(ws + OFF_Z + 28 * MiB);
  const bf16_t* AKW = (const bf16_t*)(ws + OFF_Z + 32 * MiB);
  const bf16_t* AVWT = (const bf16_t*)(ws + OFF_Z + 36 * MiB);
  const float* AG = (const float*)(ws + OFF_Z + 80 * MiB);
  const bf16_t* KCMP = (const bf16_t*)(ws + OFF_X + 8 * MiB);
  const bf16_t* VCMPT = (const bf16_t*)(ws + OFF_X + 8 * MiB + 256 * 1024);
  const int tid = lv(threadIdx.x), lane = tid & 63, w = tid >> 6, q = lane & 15, g4 = lane >> 4;
  const int sub = w & 1, hp = w >> 1;
  const int t0 = ch * 32, tq = t0 + 16 * sub + q;
  const size_t tokrow = (size_t)b * S_ + tq;
  const int bg = b * 2 + g;
  const int h0 = g * 4 + 2 * hp;
  bf16x8 Qf[2][2];
#pragma unroll
  for (int c = 0; c < 2; ++c)
#pragma unroll
    for (int ks = 0; ks < 2; ++ks) Qf[c][ks] = *(const bf16x8*)(AQ + (tokrow * 8 + h0 + c) * 64 + ks * 32 + g4 * 8);
  const float* gap = AG + tokrow * 24 + h0 * 3;
  float* imp = (float*)(smem + L_IMP);
  unsigned short* selm = (unsigned short*)(smem + L_SELM);
  unsigned* uni = (unsigned*)(smem + L_UNI);
  __syncthreads();
  for (int i = tid; i < 2 * 32 * 132; i += 256) imp[i] = 0.f;
  if (tid < 4) uni[tid] = 0u;
  const float sc2 = 0.125f * LOG2E;
  const bf16_t* Kc = KCMP + (size_t)bg * 512 * 64;
  const bf16_t* Vc = VCMPT + (size_t)bg * 64 * 512;
  const int nct = ((t0 >> 4) + 1 + 63) >> 6;
  float m[2] = {-1e28f, -1e28f}, l[2] = {0.f, 0.f};
  f32x4 O[2][4];
  f32x4 Ot[2][4];
#pragma unroll
  for (int c = 0; c < 2; ++c)
#pragma unroll
    for (int dt = 0; dt < 4; ++dt) { const float z_ = lz0(); O[c][dt] = f32x4{z_, z_, z_, z_}; }
  KVREGS(rg, 64);
  kv_gload(64, false, rg, Kc, Vc, 512);
  for (int tile = 0; tile < nct; ++tile) {
    __syncthreads();
    kv_sstore(64, false, rg, smem);
    __syncthreads();
    if (tile + 1 < nct) kv_gload(64, false, rg, Kc + (size_t)(tile + 1) * 64 * 64, Vc, 512);
    const int kx_ = ((tq - 31) >> 4) - 64 * tile;
    const int kmx[2] = {kx_, kx_}, kmn[2] = {0, 0};
    attn_tile<2, 2, 1, 1>(smem, Qf, O, m, l, sc2, kmx, kmn, nullptr, 0);
  }
  attn_finish<2>(O, l);
  kv_gload(64, true, rg, Kc, Vc, 512);
  float* improw = imp + (hp * 32 + 16 * sub + q) * 132;
  for (int tile = 0; tile < nct; ++tile) {
    __syncthreads();
    kv_sstore(64, true, rg, smem);
    __syncthreads();
    if (tile + 1 < nct) kv_gload(64, true, rg, Kc + (size_t)(tile + 1) * 64 * 64, Vc + (tile + 1) * 64, 512);
    const int kx_ = ((tq - 31) >> 4) - 64 * tile;
    const int kmx[2] = {kx_, kx_}, kmn[2] = {0, 0};
    attn_tile<2, 2, 2, 1>(smem, Qf, O, m, l, sc2, kmx, kmn, improw, tile * 16);
  }
#pragma unroll
  for (int c = 0; c < 2; ++c)
#pragma unroll
    for (int dt = 0; dt < 4; ++dt) Ot[c][dt] = O[c][dt] * gap[c * 3];
  __syncthreads();
  const int cur = t0 >> 6;
  {
    const int tok = tid >> 3, s8 = tid & 7;
    const float* i0 = imp + tok * 132;
    const float* i1 = imp + (32 + tok) * 132;
    unsigned mask16 = 0;
    if (cur < 16) {
#pragma unroll
      for (int jj = 0; jj < 16; ++jj) mask16 |= ((s8 * 16 + jj) <= cur) ? (1u << jj) : 0u;
    } else {
      unsigned long long key[16];
#pragma unroll
      for (int jj = 0; jj < 16; ++jj) {
        const int j = s8 * 16 + jj;
        const float v = (i0[j] + i1[j]) + ((j == 0 || j == cur || j == cur - 1) ? 1e4f : 0.f);
        const unsigned kb = (j <= cur) ? (__float_as_uint(v) + 1u) : 0u;
        key[jj] = ((unsigned long long)kb << 8) | (unsigned long long)(127 - j);
      }
#pragma unroll 1
      for (int r = 0; r < 16; ++r) {
        unsigned long long mx = key[0];
#pragma unroll
        for (int jj = 1; jj < 16; ++jj) mx = key[jj] > mx ? key[jj] : mx;
#pragma unroll
        for (int o = 1; o < 8; o <<= 1) {
          const unsigned long long ot = __shfl_xor(mx, o);
          mx = ot > mx ? ot : mx;
        }
#pragma unroll
        for (int jj = 0; jj < 16; ++jj) {
          const bool hit = key[jj] == mx;
          mask16 |= hit ? (1u << jj) : 0u;
          key[jj] = hit ? 0ull : key[jj];
        }
      }
    }
    selm[tok * 8 + s8] = (unsigned short)mask16;
    if (mask16) atomicOr(&uni[s8 >> 1], mask16 << ((s8 & 1) * 16));
  }
  __syncthreads();
  unsigned mkb[4], un[4];
  {
    const unsigned short* sm = selm + (16 * sub + q) * 8;
#pragma unroll
    for (int i = 0; i < 4; ++i) {
      mkb[i] = (unsigned)sm[2 * i] | ((unsigned)sm[2 * i + 1] << 16);
      un[i] = uni[i];
    }
  }
  {
    const bf16_t* Ks = AKS + (size_t)bg * S_ * 64;
    const bf16_t* Vs = AVST + (size_t)bg * 64 * S_;
    m[0] = m[1] = -1e28f;
    l[0] = l[1] = 0.f;
#pragma unroll
    for (int c = 0; c < 2; ++c)
#pragma unroll
      for (int dt = 0; dt < 4; ++dt) { const float z_ = lz0(); O[c][dt] = f32x4{z_, z_, z_, z_}; }
    auto nextset = [&](int from) {
      for (int j = from; j <= cur; ++j)
        if ((un[j >> 5] >> (j & 31)) & 1u) return j;
      return -1;
    };
    int j = nextset(0);
    if (j >= 0) kv_gload(64, true, rg, Ks + (size_t)j * 64 * 64, Vs + j * 64, S_);
    while (j >= 0) {
      __syncthreads();
      kv_sstore(64, true, rg, smem);
      __syncthreads();
      const int jn = nextset(j + 1);
      if (jn >= 0) kv_gload(64, true, rg, Ks + (size_t)jn * 64 * 64, Vs + jn * 64, S_);
      const bool bit = (mkb[j >> 5] >> (j & 31)) & 1u;
      if (__ballot(bit) != 0ull) {
        const int kx_ = bit ? (tq - 64 * j) : -1;
        const int kmx[2] = {kx_, kx_}, kmn[2] = {0, 0};
        attn_tile<2, 2, 0, 1>(smem, Qf, O, m, l, sc2, kmx, kmn, nullptr, 0);
      }
      j = jn;
    }
    attn_finish<2>(O, l);
#pragma unroll
    for (int c = 0; c < 2; ++c)
#pragma unroll
      for (int dt = 0; dt < 4; ++dt) Ot[c][dt] += O[c][dt] * (l[c] * gap[c * 3 + 1]);
  }
  {
    const bf16_t* Kw = AKW + (size_t)bg * S_ * 64;
    const bf16_t* Vw = AVWT + (size_t)bg * 64 * S_;
    m[0] = m[1] = -1e28f;
    l[0] = l[1] = 0.f;
#pragma unroll
    for (int c = 0; c < 2; ++c)
#pragma unroll
      for (int dt = 0; dt < 4; ++dt) { const float z_ = lz0(); O[c][dt] = f32x4{z_, z_, z_, z_}; }
    int jlo = (t0 - 511) >> 6;
    if (jlo < 0) jlo = 0;
    const int jhi = t0 >> 6;
    kv_gload(64, true, rg, Kw + (size_t)jlo * 64 * 64, Vw + jlo * 64, S_);
    for (int j = jlo; j <= jhi; ++j) {
      __syncthreads();
      kv_sstore(64, true, rg, smem);
      __syncthreads();
      if (j + 1 <= jhi) kv_gload(64, true, rg, Kw + (size_t)(j + 1) * 64 * 64, Vw + (j + 1) * 64, S_);
      const int kx_ = tq - 64 * j, kn_ = tq - 511 - 64 * j;
      const int kmx[2] = {kx_, kx_}, kmn[2] = {kn_, kn_};
      attn_tile<2, 2, 0, 2>(smem, Qf, O, m, l, sc2, kmx, kmn, nullptr, 0);
    }
    attn_finish<2>(O, l);
#pragma unroll
    for (int c = 0; c < 2; ++c)
#pragma unroll
      for (int dt = 0; dt < 4; ++dt) Ot[c][dt] += O[c][dt] * (l[c] * gap[c * 3 + 2]);
  }
#pragma unroll
  for (int c = 0; c < 2; ++c)
#pragma unroll
    for (int dt = 0; dt < 4; ++dt) {
      uint2 o;
      o.x = pack2(Ot[c][dt][0], Ot[c][dt][1]);
      o.y = pack2(Ot[c][dt][2], Ot[c][dt][3]);
      *(uint2*)(AQ + (tokrow * 8 + h0 + c) * 64 + dt * 16 + 4 * g4) = o;
    }
}

DI void swa_item(const Params& P, char* ws, int layer, int b, int g, int ch, char* smem) {
  bf16_t* BQ = (bf16_t*)(ws + OFF_Z + 40 * MiB);
  const bf16_t* BK = (const bf16_t*)(ws + OFF_Z + 56 * MiB);
  const bf16_t* BVT = (const bf16_t*)(ws + OFF_Z + 60 * MiB);
  const float* sinks = gptr(P.in[11]) + layer * 8;
  const int tid = lv(threadIdx.x), lane = tid & 63, w = tid >> 6, q = lane & 15, g4 = lane >> 4;
  const int sub = w & 1, hp = w >> 1;
  const int t0 = ch * 32, tq = t0 + 16 * sub + q;
  const size_t tokrow = (size_t)b * S_ + tq;
  const int bg = b * 2 + g;
  const int h0 = g * 4 + 2 * hp;
  bf16x8 Qf[2][2];
#pragma unroll
  for (int c = 0; c < 2; ++c)
#pragma unroll
    for (int ks = 0; ks < 2; ++ks) Qf[c][ks] = *(const bf16x8*)(BQ + (tokrow * 8 + h0 + c) * 64 + ks * 32 + g4 * 8);
  const float sc2 = 0.125f * LOG2E;
  float m[2], l[2];
  f32x4 O[2][4];
#pragma unroll
  for (int c = 0; c < 2; ++c) {
    m[c] = sinks[h0 + c] * 8.f;
    l[c] = (g4 == 0) ? 1.f : 0.f;
#pragma unroll
    for (int dt = 0; dt < 4; ++dt) { const float z_ = lz0(); O[c][dt] = f32x4{z_, z_, z_, z_}; }
  }
  const bf16_t* Kb = BK + (size_t)bg * S_ * 64;
  const bf16_t* Vb = BVT + (size_t)bg * 64 * S_;
  int jlo = (t0 - 127) >> 6;
  if (jlo < 0) jlo = 0;
  const int jhi = t0 >> 6;
  KVREGS(rg, 64);
  kv_gload(64, true, rg, Kb + (size_t)jlo * 64 * 64, Vb + jlo * 64, S_);
  for (int j = jlo; j <= jhi; ++j) {
    __syncthreads();
    kv_sstore(64, true, rg, smem);
    __syncthreads();
    if (j + 1 <= jhi) kv_gload(64, true, rg, Kb + (size_t)(j + 1) * 64 * 64, Vb + (j + 1) * 64, S_);
    const int kx_ = tq - 64 * j, kn_ = tq - 127 - 64 * j;
    const int kmx[2] = {kx_, kx_}, kmn[2] = {kn_, kn_};
    attn_tile<2, 2, 0, 2>(smem, Qf, O, m, l, sc2, kmx, kmn, nullptr, 0);
  }
  attn_finish<2>(O, l);
#pragma unroll
  for (int c = 0; c < 2; ++c)
#pragma unroll
    for (int dt = 0; dt < 4; ++dt) {
      uint2 o;
      o.x = pack2(O[c][dt][0] * l[c], O[c][dt][1] * l[c]);
      o.y = pack2(O[c][dt][2] * l[c], O[c][dt][3] * l[c]);
      *(uint2*)(BQ + (tokrow * 8 + h0 + c) * 64 + dt * 16 + 4 * g4) = o;
    }
}

DI void mla_item(const Params& P, char* ws, int b, int h, int qb, char* smem) {
  const bf16_t* CQF = (const bf16_t*)(ws + OFF_M);
  const bf16_t* CK = (const bf16_t*)(ws + OFF_M + 24 * MiB);
  const bf16_t* CVT = (const bf16_t*)(ws + OFF_M + 48 * MiB);
  bf16_t* OC = (bf16_t*)(ws + OFF_Z + 64 * MiB);
  const int tid = lv(threadIdx.x), lane = tid & 63, w = tid >> 6, q = lane & 15, g4 = lane >> 4;
  const int t0 = qb * 128;
  int tq[2];
  bf16x8 Qf[2][3];
#pragma unroll
  for (int c = 0; c < 2; ++c) {
    tq[c] = t0 + 32 * w + 16 * c + q;
#pragma unroll
    for (int ks = 0; ks < 3; ++ks)
      Qf[c][ks] = *(const bf16x8*)(CQF + (((size_t)b * S_ + tq[c]) * 8 + h) * 96 + ks * 32 + g4 * 8);
  }
  const float sc2 = 0.10206207261596575f * LOG2E;
  float m[2] = {-1e28f, -1e28f}, l[2] = {0.f, 0.f};
  f32x4 O[2][4];
#pragma unroll
  for (int c = 0; c < 2; ++c)
#pragma unroll
    for (int dt = 0; dt < 4; ++dt) { const float z_ = lz0(); O[c][dt] = f32x4{z_, z_, z_, z_}; }
  const bf16_t* Kb = CK + (size_t)(b * 8 + h) * S_ * 96;
  const bf16_t* Vb = CVT + (size_t)(b * 8 + h) * 64 * S_;
  const int ntile = 2 * qb + 2;
  const int wmax = t0 + 32 * w + 31, wmin = t0 + 32 * w;
  KVREGS(rg, 96);
  kv_gload(96, true, rg, Kb, Vb, S_);
  for (int j = 0; j < ntile; ++j) {
    __syncthreads();
    kv_sstore(96, true, rg, smem);
    __syncthreads();
    if (j + 1 < ntile) kv_gload(96, true, rg, Kb + (size_t)(j + 1) * 64 * 96, Vb + (j + 1) * 64, S_);
    if (j * 64 <= wmax) {
      const int kmx[2] = {tq[0] - 64 * j, tq[1] - 64 * j}, kmn[2] = {0, 0};
      if (j * 64 + 63 <= wmin) attn_tile<2, 3, 0, 0>(smem, Qf, O, m, l, sc2, kmx, kmn, nullptr, 0);
      else attn_tile<2, 3, 0, 1>(smem, Qf, O, m, l, sc2, kmx, kmn, nullptr, 0);
    }
  }
  attn_finish<2>(O, l);
#pragma unroll
  for (int c = 0; c < 2; ++c)
#pragma unroll
    for (int dt = 0; dt < 4; ++dt) {
      uint2 o;
      o.x = pack2(O[c][dt][0] * l[c], O[c][dt][1] * l[c]);
      o.y = pack2(O[c][dt][2] * l[c], O[c][dt][3] * l[c]);
      *(uint2*)(OC + ((size_t)b * S_ + tq[c]) * 512 + h * 64 + dt * 16 + 4 * g4) = o;
    }
}

#define XB_TMO      128
#define XB_XCNT(j)  (256  + 64 * (j))
#define XB_XSUB(j)  (1280 + 64 * (j))
#define XB_XGEN(j)  (2304 + 64 * (j))
#define XB_TOP      3328
#define XB_TOPGEN   3392
#define XCD_BAR_WORDS 3456
#define XB_SPIN_CAP (1u << 18)
#define LAS __attribute__((address_space(3)))

__device__ __forceinline__ unsigned xb_ld(unsigned* p)              { return __hip_atomic_load(p, __ATOMIC_RELAXED, __HIP_MEMORY_SCOPE_AGENT); }
__device__ __forceinline__ unsigned xb_add(unsigned* p, unsigned v) { return __hip_atomic_fetch_add(p, v, __ATOMIC_RELAXED, __HIP_MEMORY_SCOPE_AGENT); }
__device__ __forceinline__ unsigned xb_xcc_id() { return (unsigned)__builtin_amdgcn_s_getreg((3 << 11) | 20) & 0xFu; }
#define XB_SPIN(cond, bar) do { unsigned _sp = 0; while (cond) { __builtin_amdgcn_s_sleep(1); \
    if ((++_sp & 255u) == 0u) { if (xb_ld(&(bar)[XB_TMO])) break; if (_sp > XB_SPIN_CAP) { atomicAdd(&(bar)[XB_TMO], 1u); break; } } } } while (0)

struct XcdBarrier {
    unsigned* bar; unsigned x;
    volatile LAS unsigned* st;
};

__device__ __forceinline__ XcdBarrier xcd_barrier_post(unsigned* bar, volatile LAS unsigned* st) {
    XcdBarrier b; b.bar = bar; b.x = xb_xcc_id(); b.st = st;
    if (threadIdx.x == 0) (void)xb_add(&bar[XB_XCNT(b.x)], 1u);
    return b;
}
__device__ __forceinline__ void xcd_barrier_complete(unsigned* bar, unsigned x, unsigned& nloc, unsigned& nx) {
    const unsigned G = gridDim.x * gridDim.y * gridDim.z;
    unsigned sum, cnt, mine, sp = 0u;
    for (;;) {
        sum = 0u; cnt = 0u; mine = 0u;
#pragma unroll
        for (unsigned j = 0; j < 16; ++j) { const unsigned c = xb_ld(&bar[XB_XCNT(j)]); sum += c; cnt += (c > 0u) ? 1u : 0u; mine = (j == x) ? c : mine; }
        if (sum == G) break;
        __builtin_amdgcn_s_sleep(1);
        if ((++sp & 255u) == 0u) { if (xb_ld(&bar[XB_TMO])) break; if (sp > XB_SPIN_CAP) { atomicAdd(&bar[XB_TMO], 1u); break; } }
    }
    nloc = mine > 0u ? mine : 1u; nx = cnt > 0u ? cnt : 1u;
}

__device__ __forceinline__ void xcd_barrier(const XcdBarrier& b) {
    asm volatile("s_waitcnt vmcnt(0)" ::: "memory");
    __syncthreads();
    if (threadIdx.x == 0) {
        unsigned* bar = b.bar;
        const unsigned bx_ = xb_xcc_id();
        __builtin_amdgcn_s_waitcnt(0);
        unsigned nloc = b.st[0], nx = b.st[1];
        if (nloc == 0u) { xcd_barrier_complete(bar, bx_, nloc, nx); b.st[0] = nloc; b.st[1] = nx; }
        const unsigned old = xb_add(&bar[XB_XSUB(bx_)], 1u);
        const unsigned gen = old / nloc;
        if (old + 1u == (gen + 1u) * nloc) {
            __builtin_amdgcn_fence(__ATOMIC_RELEASE, "agent");
            asm volatile("s_waitcnt vmcnt(0)" ::: "memory");
            const unsigned og = xb_add(&bar[XB_TOP], 1u);
            const unsigned tg = og / nx;
            if (og + 1u == (tg + 1u) * nx) xb_add(&bar[XB_TOPGEN], 1u);
            else XB_SPIN(xb_ld(&bar[XB_TOPGEN]) == tg, bar);
            __builtin_amdgcn_fence(__ATOMIC_ACQUIRE, "agent");
            xb_add(&bar[XB_XGEN(bx_)], 1u);
            asm volatile("s_waitcnt vmcnt(0)" ::: "memory");
        } else {
            XB_SPIN(xb_ld(&bar[XB_XGEN(bx_)]) == gen, bar);
            __builtin_amdgcn_fence(__ATOMIC_ACQUIRE, "agent");
            asm volatile("s_waitcnt vmcnt(0)" ::: "memory");
        }
    }
    __syncthreads();
}


DI void tile_map(int q, int Nt, bool xcd, int& mt, int& nt) {
  if (!xcd) { mt = q / Nt; nt = q % Nt; return; }
  const int c = q >> 7;
  int ml, nl, mg;
  if (8 * c + 8 <= Nt) {
    const int r = q & 127;
    ml = r & 7; nl = (r >> 3) & 7; mg = r >> 6;
  } else {
    const int wN = Nt - 8 * c, r = q - 128 * c, rest = r >> 3;
    ml = r & 7; nl = rest % wN; mg = rest / wN;
  }
  mt = 16 * (int)(blockIdx.x & 7) + 8 * mg + ml;
  nt = 8 * c + nl;
}
#define TILE_LOOP(Nt) for (int q_ = (xcdmap ? (int)(blockIdx.x >> 3) : vbid); q_ < (xcdmap ? 16 * (Nt) : 128 * (Nt)); q_ += (xcdmap ? 64 : G))

#define DECL_PTRS \
  bf16_t* Wb = (bf16_t*)(ws + OFF_W); \
  bf16_t* H = (bf16_t*)(ws + OFF_H); \
  bf16_t* AQ = (bf16_t*)(ws + OFF_Z); \
  bf16_t* AKC = (bf16_t*)(ws + OFF_Z + 16 * MiB); \
  bf16_t* BQ = (bf16_t*)(ws + OFF_Z + 40 * MiB); \
  bf16_t* BK = (bf16_t*)(ws + OFF_Z + 56 * MiB); \
  bf16_t* BVT = (bf16_t*)(ws + OFF_Z + 60 * MiB); \
  bf16_t* CQ = (bf16_t*)(ws + OFF_Z + 64 * MiB); \
  bf16_t* CKV = (bf16_t*)(ws + OFF_Z + 72 * MiB); \
  float* AG = (float*)(ws + OFF_Z + 80 * MiB); \
  bf16_t* CQF = (bf16_t*)(ws + OFF_M); \
  bf16_t* CK = (bf16_t*)(ws + OFF_M + 24 * MiB); \
  bf16_t* CVT = (bf16_t*)(ws + OFF_M + 48 * MiB); \
  bf16_t* MERGED = (bf16_t*)(ws + OFF_M); \
  bf16_t* ACT = (bf16_t*)(ws + OFF_Z); \
  float* COS64 = (float*)(ws + OFF_X); \
  float* SIN64 = (float*)(ws + OFF_X + 2 * MiB); \
  float* COS32 = (float*)(ws + OFF_X + 4 * MiB); \
  float* SIN32 = (float*)(ws + OFF_X + 5 * MiB); \
  bf16_t* HID = (bf16_t*)(ws + OFF_X + 6 * MiB); \
  bf16_t* KCMP = (bf16_t*)(ws + OFF_X + 8 * MiB); \
  bf16_t* VCMPT = (bf16_t*)(ws + OFF_X + 8 * MiB + 256 * 1024); \
  float* BIAS = (float*)(ws + OFF_X + 8 * MiB + 512 * 1024); \
  bf16_t* PB = (bf16_t*)(ws + OFF_X + 10 * MiB);

__global__ void __launch_bounds__(256, 2) mega(Params P) {
  cg::grid_group grid = cg::this_grid();
  __shared__ __attribute__((aligned(16))) char smem[SMEM_BYTES];
  char* ws0 = P.ws;
  __shared__ uint4 xb_words;
  if (threadIdx.x == 0) xb_words = make_uint4(0u, 0u, 0u, 0u);
  __syncthreads();
  if (P.ws == nullptr) grid.sync();
  const XcdBarrier xb = xcd_barrier_post((unsigned*)(ws0 + OFF_BAR), (volatile LAS unsigned*)&xb_words);
  const int G = gridDim.x;
  const bool xcdmap = (G == 512);
  const int vbid = (G & 7) ? (int)blockIdx.x : (int)((blockIdx.x & 7) * (G >> 3) + (blockIdx.x >> 3));

  float* xo = gptr(P.out);

  {
    char* ws = launder(ws0);
    DECL_PTRS
    const int tid = lv(threadIdx.x);
    const int gtid = blockIdx.x * 256 + tid, gthreads = ls(G) * 256;
    (void)Wb; (void)H;
        const int* posi = (const int*)gptr(P.in[2]);
        for (int i = gtid; i < T_ * 32; i += gthreads) {
          const int t = i >> 5, ff = i & 31;
          float c, sn;
          sincos_acc((float)posi[t] * INVF64[ff], c, sn);
          COS64[i] = c;
          SIN64[i] = sn;
        }
        for (int i = gtid; i < T_ * 16; i += gthreads) {
          const int t = i >> 4, ff = i & 15;
          float c, sn;
          sincos_acc((float)posi[t] * INVF64[2 * ff], c, sn);
          COS32[i] = c;
          SIN32[i] = sn;
        }
      }
  for (int layer = 0; layer < 2; ++layer) {
    const float* xi = layer == 0 ? gptr(P.in[0]) : (const float*)gptr(P.out);
    {
      char* ws = launder(ws0);
      DECL_PTRS
      const int tid = lv(threadIdx.x), lane = tid & 63, w = tid >> 6, wm = w >> 1, wn = w & 1, f = lane & 31, hi = lane >> 5;
      const int gtid = blockIdx.x * 256 + tid, gthreads = ls(G) * 256;
      (void)wm; (void)wn; (void)f; (void)hi; (void)gtid; (void)gthreads; (void)w;
    {
      int base = 0;
      const float* w_in = gptr(P.in[4]) + (size_t)layer * 1024 * 2616;
      conv_seg(w_in, 2616, 0, 1280, 1024, Wb + W_IN, 0, base, smem);
      conv_seg(w_in, 2616, 1304, 1312, 1024, Wb + W_IN, 1280, base, smem);
      conv_seg(w_in, 2616, 1280, 24, 1024, Wb + W_IN, 2592, base, smem);
      conv_seg(gptr(P.in[6]) + (size_t)layer * 2048 * 256, 256, 0, 256, 2048, Wb + W_1K, 0, base, smem);
      conv_seg(gptr(P.in[9]) + (size_t)layer * 2048 * 256, 256, 0, 256, 2048, Wb + W_1V, 0, base, smem);
      conv_seg(gptr(P.in[7]) + (size_t)layer * 256 * 64, 64, 0, 64, 256, Wb + W_2K, 0, base, smem);
      conv_seg(gptr(P.in[10]) + (size_t)layer * 256 * 64, 64, 0, 64, 256, Wb + W_2V, 0, base, smem);
      {
        const float* wq = gptr(P.in[13]) + (size_t)layer * 256 * 768;
        const float* wkv = gptr(P.in[15]) + (size_t)layer * 256 * 1024;
        for (int h = 0; h < 8; ++h) {
          conv_seg(wq, 768, h * 96, 64, 256, Wb + W_QUP, h * 64, base, smem);
          conv_seg(wq, 768, h * 96 + 64, 32, 256, Wb + W_QUP, 512 + h * 32, base, smem);
          conv_seg(wkv, 1024, h * 128, 64, 256, Wb + W_KVUP, h * 64, base, smem);
          conv_seg(wkv, 1024, h * 128 + 64, 64, 256, Wb + W_KVUP, 512 + h * 64, base, smem);
        }
      }
      conv_seg(gptr(P.in[16]) + (size_t)layer * 1024 * 3072, 3072, 0, 3072, 1024, Wb + W_G, 0, base, smem);
      conv_seg(gptr(P.in[17]) + (size_t)layer * 512 * 1024, 1024, 0, 1024, 512, Wb + W_PA, 0, base, smem);
      conv_seg(gptr(P.in[18]) + (size_t)layer * 512 * 1024, 1024, 0, 1024, 512, Wb + W_PB, 0, base, smem);
      conv_seg(gptr(P.in[19]) + (size_t)layer * 512 * 1024, 1024, 0, 1024, 512, Wb + W_PC, 0, base, smem);
      conv_seg(gptr(P.in[20]) + (size_t)layer * 1024 * 1024, 1024, 0, 1024, 1024, Wb + W_OUT, 0, base, smem);
      {
        const float* wg = gptr(P.in[22]) + (size_t)layer * 1024 * DFF;
        const float* wu = gptr(P.in[23]) + (size_t)layer * 1024 * DFF;
        conv_seg<true>(wg, DFF, 0, DFF, 1024, Wb + W_GU, 0, base, smem);
        conv_seg<true>(wu, DFF, 0, DFF, 1024, Wb + W_GU, 32, base, smem);
      }
      conv_seg(gptr(P.in[24]) + (size_t)layer * DFF * 1024, 1024, 0, 1024, DFF, Wb + W_DOWN, 0, base, smem);
      conv_seg(gptr(P.in[26]) + (size_t)layer * 256 * 1024, 1024, 0, 1024, 256, Wb + W_PLEP, 0, base, smem);
      conv_seg(gptr(P.in[27]) + (size_t)layer * 1024 * 1024, 1024, 0, 1024, 1024, Wb + W_PLEG, 0, base, smem);
      const unsigned zu_ = (unsigned)lv(0);
      for (int i = gtid; i < 72 * 1024 / 8; i += gthreads) ((uint4*)(Wb + W_IN + 2616ull * 1024))[i] = make_uint4(zu_, zu_, zu_, zu_);
      for (int i = gtid; i < 2 * 64 * 256 / 8; i += gthreads) {
        const int which = i / (64 * 256 / 8), r = i % (64 * 256 / 8);
        ((uint4*)(Wb + (which ? W_2V : W_2K) + 64ull * 256))[r] = make_uint4(zu_, zu_, zu_, zu_);
      }
      __syncthreads();
      if (blockIdx.x < 16) {
        const int which = blockIdx.x >> 3, part = blockIdx.x & 7;
        const float* pos = gptr(P.in[which ? 8 : 5]) + (size_t)layer * 2048;
        const float* w1 = gptr(P.in[which ? 9 : 6]) + (size_t)layer * 2048 * 256;
        const int c = tid & 31, ks = tid >> 5;
        float sacc = 0.f;
        for (int k = ks * 256; k < ks * 256 + 256; ++k) sacc += pos[k] * w1[(size_t)k * 256 + part * 32 + c];
        float* red = (float*)smem;
        red[tid] = sacc;
        __syncthreads();
        if (tid < 32) {
          float t = 0.f;
          for (int i = 0; i < 8; ++i) t += red[i * 32 + tid];
          BIAS[which * 256 + part * 32 + tid] = t;
        }
      }
      {
        const float* pp = gptr(P.in[1]) + (size_t)layer * T_ * 256;
        for (int i = gtid; i < T_ * 256 / 4; i += gthreads) {
          const float4 v = ((const float4*)pp)[i];
          uint2 o;
          o.x = pack2(v.x, v.y);
          o.y = pack2(v.z, v.w);
          ((uint2*)PB)[i] = o;
        }
      }
      norm_rows_f32(xi, gptr(P.in[3]) + layer * DM, H);
    }
    }
    xcd_barrier(xb);
    {
      char* ws = launder(ws0);
      DECL_PTRS
      const int tid = lv(threadIdx.x), lane = tid & 63, w = tid >> 6, wm = w >> 1, wn = w & 1, f = lane & 31, hi = lane >> 5;
      const int gtid = blockIdx.x * 256 + tid, gthreads = ls(G) * 256;
      (void)wm; (void)wn; (void)f; (void)hi; (void)gtid; (void)gthreads; (void)w;
    TILE_LOOP(20) {
      int mt, nt;
      tile_map(q_, 20, xcdmap, mt, nt);
      const int m0 = mt * 128;
      f32x16 acc[2][2];
      zero_acc<2>(acc);
      mma_block<2>(H + (size_t)m0 * DM, DM, Wb + W_IN + (size_t)nt * 128 * 1024, 1024, 1024, acc, smem);
      const int seg = nt * 2 + wn;
      int kind, hh = 0;
      bf16_t* dst = nullptr;
      if (seg < 8) { kind = 0; dst = AQ; hh = seg; }
      else if (seg < 20) {
        const int a = (seg - 8) >> 1;
        hh = (seg - 8) & 1;
        dst = AKC + (size_t)a * (2 * MiB);
        kind = (a == 0 || a == 2 || a == 4) ? 1 : (a == 1 ? 2 : 3);
      }
      else if (seg < 28) { kind = 0; dst = BQ; hh = seg - 20; }
      else if (seg < 30) { kind = 1; dst = BK; hh = seg - 28; }
      else if (seg < 32) { kind = 3; dst = BVT; hh = seg - 30; }
      else if (seg < 36) { kind = 4; dst = CQ + (seg - 32) * 64; }
      else if (seg < 40) { kind = 4; dst = CKV + (seg - 36) * 64; }
      else if (seg == 40) kind = 5;
      else kind = 6;
#pragma unroll
      for (int mi = 0; mi < 2; ++mi) {
#pragma unroll
        for (int i4 = 0; i4 < 4; ++i4) {
          const int tb = m0 + wm * 64 + mi * 32 + 8 * i4 + 4 * hi;
          const int b = tb >> 13, s0 = tb & 8191;
          if (kind == 3) {
            uint2 o0, o1;
            o0.x = pack2(acc[mi][0][4 * i4], acc[mi][0][4 * i4 + 1]);
            o0.y = pack2(acc[mi][0][4 * i4 + 2], acc[mi][0][4 * i4 + 3]);
            o1.x = pack2(acc[mi][1][4 * i4], acc[mi][1][4 * i4 + 1]);
            o1.y = pack2(acc[mi][1][4 * i4 + 2], acc[mi][1][4 * i4 + 3]);
            *(uint2*)(dst + ((size_t)(b * 2 + hh) * 64 + f) * S_ + s0) = o0;
            *(uint2*)(dst + ((size_t)(b * 2 + hh) * 64 + f + 32) * S_ + s0) = o1;
          } else if (kind != 6) {
#pragma unroll
            for (int e = 0; e < 4; ++e) {
              const int t = tb + e, s = s0 + e;
              const float v0 = acc[mi][0][4 * i4 + e], v1 = acc[mi][1][4 * i4 + e];
              if (kind <= 1) {
                const float c = COS64[t * 32 + f], sn = SIN64[t * 32 + f];
                const float r0 = v0 * c - v1 * sn, r1 = v1 * c + v0 * sn;
                const size_t idx = kind == 0 ? ((size_t)t * 8 + hh) * 64 + f : ((size_t)(b * 2 + hh) * S_ + s) * 64 + f;
                dst[idx] = f2bf(r0);
                dst[idx + 32] = f2bf(r1);
              } else if (kind == 2) {
                const size_t idx = ((size_t)(b * 2 + hh) * S_ + s) * 64 + f;
                dst[idx] = f2bf(v0);
                dst[idx + 32] = f2bf(v1);
              } else if (kind == 4) {
                dst[(size_t)t * 256 + f] = f2bf(v0);
                dst[(size_t)t * 256 + f + 32] = f2bf(v1);
              } else {
                const float c = COS32[t * 16 + (f & 15)], sn = SIN32[t * 16 + (f & 15)];
                const float pr = __shfl_xor(v0, 16);
                const float r = (f < 16) ? v0 * c - pr * sn : v0 * c + pr * sn;
                const bf16_t rb = f2bf(r);
#pragma unroll
                for (int h = 0; h < 8; ++h) CK[((size_t)(b * 8 + h) * S_ + s) * 96 + 64 + f] = rb;
                if (f < 24) AG[(size_t)t * 24 + f] = sigmoidf_(v1);
              }
            }
          }
        }
      }
    }
    }
    xcd_barrier(xb);
    {
      char* ws = launder(ws0);
      DECL_PTRS
      const int tid = lv(threadIdx.x), lane = tid & 63, w = tid >> 6, wm = w >> 1, wn = w & 1, f = lane & 31, hi = lane >> 5;
      const int gtid = blockIdx.x * 256 + tid, gthreads = ls(G) * 256;
      (void)wm; (void)wn; (void)f; (void)hi; (void)gtid; (void)gthreads; (void)w;
    for (int tix = vbid - 64; tix < 128; tix += G) {
      if (tix < 0) continue;
      const int m0 = tix * 128;
      f32x16 acc[2][1];
      zero_acc<1>(acc);
      mma_block<1>(H + (size_t)m0 * DM, DM, Wb + W_IN + (size_t)2560 * 1024, 1024, 1024, acc, smem);
#pragma unroll
      for (int mi = 0; mi < 2; ++mi)
#pragma unroll
        for (int i = 0; i < 16; ++i) {
          const int t = m0 + wm * 64 + mi * 32 + (i & 3) + 8 * (i >> 2) + 4 * hi;
          const int b = t >> 13, sx = t & 8191;
          const float v0 = acc[mi][0][i];
          if (wn == 0) {
            const float c = COS32[t * 16 + (f & 15)], sn = SIN32[t * 16 + (f & 15)];
            const float pr = __shfl_xor(v0, 16);
            const float r = (f < 16) ? v0 * c - pr * sn : v0 * c + pr * sn;
            const bf16_t rb = f2bf(r);
#pragma unroll
            for (int h = 0; h < 8; ++h) CK[((size_t)(b * 8 + h) * S_ + sx) * 96 + 64 + f] = rb;
          } else if (f < 24) {
            AG[(size_t)t * 24 + f] = sigmoidf_(v0);
          }
        }
    }
    for (int tix = vbid; tix < 64; tix += G) {
      const int which = tix >> 5, mt = (tix >> 1) & 15, nt = tix & 1;
      f32x16 acc[2][2];
      zero_acc<2>(acc);
      mma_block<2>(AKC + (size_t)which * (2 * MiB) + (size_t)mt * 128 * 1024, 1024,
                   Wb + (which ? W_1V : W_1K) + (size_t)nt * 128 * 2048, 2048, 2048, acc, smem);
#pragma unroll
      for (int mi = 0; mi < 2; ++mi)
#pragma unroll
        for (int ni = 0; ni < 2; ++ni)
#pragma unroll
          for (int i = 0; i < 16; ++i) {
            const int row = mt * 128 + wm * 64 + mi * 32 + (i & 3) + 8 * (i >> 2) + 4 * hi;
            const int col = nt * 128 + wn * 64 + ni * 32 + f;
            const float x = acc[mi][ni][i] + BIAS[which * 256 + col];
            const float y = 0.5f * x * (1.f + tanhf(0.7978845608028654f * (x + 0.044715f * x * x * x)));
            HID[(size_t)which * 2048 * 256 + (size_t)row * 256 + col] = f2bf(y);
          }
    }
    for (int r = blockIdx.x * 4 + w; r < 2 * T_; r += G * 4) {
      const int which = r >= T_;
      const int row = which ? r - T_ : r;
      bf16_t* p = (which ? CKV : CQ) + (size_t)row * 256 + lane * 4;
      const float* gain = gptr(P.in[which ? 14 : 12]) + layer * 256 + lane * 4;
      const uint2 v = *(const uint2*)p;
      const float a0 = bflo(v.x), a1 = bfhi(v.x), a2 = bflo(v.y), a3 = bfhi(v.y);
      const float ss = wave_sum(a0 * a0 + a1 * a1 + a2 * a2 + a3 * a3);
      const float rs = rsqrtf(ss * (1.f / 256.f) + 1e-6f);
      uint2 o;
      o.x = pack2(a0 * rs * gain[0], a1 * rs * gain[1]);
      o.y = pack2(a2 * rs * gain[2], a3 * rs * gain[3]);
      *(uint2*)p = o;
    }
    }
    xcd_barrier(xb);
    {
      char* ws = launder(ws0);
      DECL_PTRS
      const int tid = lv(threadIdx.x), lane = tid & 63, w = tid >> 6, wm = w >> 1, wn = w & 1, f = lane & 31, hi = lane >> 5;
      const int gtid = blockIdx.x * 256 + tid, gthreads = ls(G) * 256;
      (void)wm; (void)wn; (void)f; (void)hi; (void)gtid; (void)gthreads; (void)w;
    for (int tix = vbid; tix < 768 + 1024 + 32; tix += G) {
      f32x16 acc[2][2];
      zero_acc<2>(acc);
      if (tix < 768) {
        const int mt = tix / 6, nt = tix % 6, m0 = mt * 128;
        mma_block<2>(CQ + (size_t)m0 * 256, 256, Wb + W_QUP + (size_t)nt * 128 * 256, 256, 256, acc, smem);
        const int seg = nt * 2 + wn;
#pragma unroll
        for (int mi = 0; mi < 2; ++mi)
#pragma unroll
          for (int i = 0; i < 16; ++i) {
            const int t = m0 + wm * 64 + mi * 32 + (i & 3) + 8 * (i >> 2) + 4 * hi;
            if (seg < 8) {
              bf16_t* d = CQF + ((size_t)t * 8 + seg) * 96 + f;
              d[0] = f2bf(acc[mi][0][i]);
              d[32] = f2bf(acc[mi][1][i]);
            } else {
              const float c = COS32[t * 16 + (f & 15)], sn = SIN32[t * 16 + (f & 15)];
#pragma unroll
              for (int ni = 0; ni < 2; ++ni) {
                const float v0 = acc[mi][ni][i];
                const float pr = __shfl_xor(v0, 16);
                const float r = (f < 16) ? v0 * c - pr * sn : v0 * c + pr * sn;
                CQF[((size_t)t * 8 + (seg - 8) * 2 + ni) * 96 + 64 + f] = f2bf(r);
              }
            }
          }
      } else if (tix < 768 + 1024) {
        const int u = tix - 768, mt = u >> 3, nt = u & 7, m0 = mt * 128;
        mma_block<2>(CKV + (size_t)m0 * 256, 256, Wb + W_KVUP + (size_t)nt * 128 * 256, 256, 256, acc, smem);
        const int seg = nt * 2 + wn;
#pragma unroll
        for (int mi = 0; mi < 2; ++mi)
#pragma unroll
          for (int i4 = 0; i4 < 4; ++i4) {
            const int tb = m0 + wm * 64 + mi * 32 + 8 * i4 + 4 * hi;
            const int b = tb >> 13, s0 = tb & 8191;
            if (seg < 8) {
#pragma unroll
              for (int e = 0; e < 4; ++e) {
                bf16_t* d = CK + ((size_t)(b * 8 + seg) * S_ + s0 + e) * 96 + f;
                d[0] = f2bf(acc[mi][0][4 * i4 + e]);
                d[32] = f2bf(acc[mi][1][4 * i4 + e]);
              }
            } else {
              uint2 o0, o1;
              o0.x = pack2(acc[mi][0][4 * i4], acc[mi][0][4 * i4 + 1]);
              o0.y = pack2(acc[mi][0][4 * i4 + 2], acc[mi][0][4 * i4 + 3]);
              o1.x = pack2(acc[mi][1][4 * i4], acc[mi][1][4 * i4 + 1]);
              o1.y = pack2(acc[mi][1][4 * i4 + 2], acc[mi][1][4 * i4 + 3]);
              *(uint2*)(CVT + ((size_t)(b * 8 + seg - 8) * 64 + f) * S_ + s0) = o0;
              *(uint2*)(CVT + ((size_t)(b * 8 + seg - 8) * 64 + f + 32) * S_ + s0) = o1;
            }
          }
      } else {
        const int u = tix - 1792, which = u >> 4, mt = u & 15;
        mma_block<2>(HID + (size_t)which * 2048 * 256 + (size_t)mt * 128 * 256, 256, Wb + (which ? W_2V : W_2K), 256, 256,
                     acc, smem);
        if (wn == 0) {
#pragma unroll
          for (int mi = 0; mi < 2; ++mi)
#pragma unroll
            for (int i4 = 0; i4 < 4; ++i4) {
              const int rb = mt * 128 + wm * 64 + mi * 32 + 8 * i4 + 4 * hi;
              if (which == 0) {
#pragma unroll
                for (int e = 0; e < 4; ++e) {
                  KCMP[(size_t)(rb + e) * 64 + f] = f2bf(acc[mi][0][4 * i4 + e]);
                  KCMP[(size_t)(rb + e) * 64 + f + 32] = f2bf(acc[mi][1][4 * i4 + e]);
                }
              } else {
                const int bg = rb >> 9, n0 = rb & 511;
                uint2 o0, o1;
                o0.x = pack2(acc[mi][0][4 * i4], acc[mi][0][4 * i4 + 1]);
                o0.y = pack2(acc[mi][0][4 * i4 + 2], acc[mi][0][4 * i4 + 3]);
                o1.x = pack2(acc[mi][1][4 * i4], acc[mi][1][4 * i4 + 1]);
                o1.y = pack2(acc[mi][1][4 * i4 + 2], acc[mi][1][4 * i4 + 3]);
                *(uint2*)(VCMPT + ((size_t)bg * 64 + f) * 512 + n0) = o0;
                *(uint2*)(VCMPT + ((size_t)bg * 64 + f + 32) * 512 + n0) = o1;
              }
            }
        }
      }
    }
    }
    xcd_barrier(xb);
    {
      char* ws = launder(ws0);
      DECL_PTRS
      const int tid = lv(threadIdx.x), lane = tid & 63, w = tid >> 6, wm = w >> 1, wn = w & 1, f = lane & 31, hi = lane >> 5;
      const int gtid = blockIdx.x * 256 + tid, gthreads = ls(G) * 256;
      (void)wm; (void)wn; (void)f; (void)hi; (void)gtid; (void)gthreads; (void)w;
    for (int it = blockIdx.x; it < 3072; it += G) {
      if (it < 1024) {
        const int bh = it & 15;
        const int qb = it < 512 ? 63 - (it >> 4) : ((it - 512) >> 4);
        mla_item(P, ws, bh >> 3, bh & 7, qb, smem);
      } else if (it < 2048) {
        const int u = it - 1024, bg = u & 3;
        const int ch = u < 512 ? 255 - (u >> 2) : ((u - 512) >> 2);
        nsa_item(P, ws, bg >> 1, bg & 1, ch, smem);
      } else {
        const int u = it - 2048, bg = u & 3;
        swa_item(P, ws, layer, bg >> 1, bg & 1, u >> 2, smem);
      }
    }
    }
    xcd_barrier(xb);
    {
      char* ws = launder(ws0);
      DECL_PTRS
      const int tid = lv(threadIdx.x), lane = tid & 63, w = tid >> 6, wm = w >> 1, wn = w & 1, f = lane & 31, hi = lane >> 5;
      const int gtid = blockIdx.x * 256 + tid, gthreads = ls(G) * 256;
      (void)wm; (void)wn; (void)f; (void)hi; (void)gtid; (void)gthreads; (void)w;
    TILE_LOOP(8) {
      int mt, nt;
      tile_map(q_, 8, xcdmap, mt, nt);
      const int m0 = mt * 128, n0 = nt * 128;
      uint32_t mpk[2][2][8];
#pragma unroll
      for (int mi = 0; mi < 2; ++mi)
#pragma unroll
        for (int ni = 0; ni < 2; ++ni)
#pragma unroll
          for (int i = 0; i < 8; ++i) mpk[mi][ni][i] = 0u;
#pragma unroll 1
      for (int br = 0; br < 3; ++br) {
        const bf16_t* Ob = br == 0 ? AQ : (br == 1 ? BQ : CQ);
        f32x16 acc[2][2];
        zero_acc<2>(acc);
        mma_block<2, true>(Ob + (size_t)m0 * 512, 512, Wb + W_PA + (size_t)br * 1024 * 512 + (size_t)n0 * 512, 512, 512, acc, smem);
        uint32_t pk[2][2][8];
#pragma unroll
        for (int mi = 0; mi < 2; ++mi)
#pragma unroll
          for (int ni = 0; ni < 2; ++ni)
#pragma unroll
            for (int i = 0; i < 8; ++i) pk[mi][ni][i] = pack2(acc[mi][ni][2 * i], acc[mi][ni][2 * i + 1]);
        zero_acc<2>(acc);
        mma_block<2, true>(H + (size_t)m0 * DM, DM, Wb + W_G + ((size_t)br * 1024 + n0) * 1024, 1024, 1024, acc, smem);
#pragma unroll
        for (int mi = 0; mi < 2; ++mi)
#pragma unroll
          for (int ni = 0; ni < 2; ++ni)
#pragma unroll
            for (int i = 0; i < 8; ++i) {
              const float a0 = bflo(mpk[mi][ni][i]) + sigmoidf_(acc[mi][ni][2 * i]) * bflo(pk[mi][ni][i]);
              const float a1 = bfhi(mpk[mi][ni][i]) + sigmoidf_(acc[mi][ni][2 * i + 1]) * bfhi(pk[mi][ni][i]);
              mpk[mi][ni][i] = pack2(a0, a1);
            }
      }
#pragma unroll
      for (int mi = 0; mi < 2; ++mi)
#pragma unroll
        for (int ni = 0; ni < 2; ++ni)
#pragma unroll
          for (int i = 0; i < 8; ++i) {
            const int t = m0 + wm * 64 + mi * 32 + ((2 * i) & 3) + 8 * ((2 * i) >> 2) + 4 * hi;
            bf16_t* mp = MERGED + (size_t)t * DM + n0 + wn * 64 + ni * 32 + f;
            mp[0] = (bf16_t)(mpk[mi][ni][i] & 0xffffu);
            mp[DM] = (bf16_t)(mpk[mi][ni][i] >> 16);
          }
    }
    }
    xcd_barrier(xb);
    {
      char* ws = launder(ws0);
      DECL_PTRS
      const int tid = lv(threadIdx.x), lane = tid & 63, w = tid >> 6, wm = w >> 1, wn = w & 1, f = lane & 31, hi = lane >> 5;
      const int gtid = blockIdx.x * 256 + tid, gthreads = ls(G) * 256;
      (void)wm; (void)wn; (void)f; (void)hi; (void)gtid; (void)gthreads; (void)w;
    TILE_LOOP(8) {
      int mt, nt;
      tile_map(q_, 8, xcdmap, mt, nt);
      const int m0 = mt * 128, n0 = nt * 128;
      f32x16 acc[2][2];
      zero_acc<2>(acc);
      mma_block<2>(MERGED + (size_t)m0 * DM, DM, Wb + W_OUT + (size_t)n0 * 1024, 1024, 1024, acc, smem);
#pragma unroll
      for (int mi = 0; mi < 2; ++mi)
#pragma unroll
        for (int ni = 0; ni < 2; ++ni)
#pragma unroll
          for (int i = 0; i < 16; ++i) {
            const size_t idx = (size_t)(m0 + wm * 64 + mi * 32 + (i & 3) + 8 * (i >> 2) + 4 * hi) * DM + n0 + wn * 64 + ni * 32 + f;
            xo[idx] = xi[idx] + acc[mi][ni][i];
            if ((i & 15) == 15) asm volatile("" ::: "memory");
          }
    }
    }
    xcd_barrier(xb);
    {
      char* ws = launder(ws0);
      DECL_PTRS
      const int tid = lv(threadIdx.x), lane = tid & 63, w = tid >> 6, wm = w >> 1, wn = w & 1, f = lane & 31, hi = lane >> 5;
      const int gtid = blockIdx.x * 256 + tid, gthreads = ls(G) * 256;
      (void)wm; (void)wn; (void)f; (void)hi; (void)gtid; (void)gthreads; (void)w;
    norm_rows_f32(xo, gptr(P.in[21]) + layer * DM, H);
    }
    xcd_barrier(xb);
    {
      char* ws = launder(ws0);
      DECL_PTRS
      const int tid = lv(threadIdx.x), lane = tid & 63, w = tid >> 6, wm = w >> 1, wn = w & 1, f = lane & 31, hi = lane >> 5;
      const int gtid = blockIdx.x * 256 + tid, gthreads = ls(G) * 256;
      (void)wm; (void)wn; (void)f; (void)hi; (void)gtid; (void)gthreads; (void)w;
    TILE_LOOP(44) {
      int mt, nt;
      tile_map(q_, 44, xcdmap, mt, nt);
      const int m0 = mt * 128;
      f32x16 acc[2][2];
      zero_acc<2>(acc);
      mma_block<2>(H + (size_t)m0 * DM, DM, Wb + W_GU + (size_t)nt * 128 * 1024, 1024, 1024, acc, smem);
      const int cb = (nt * 2 + wn) * 32 + f;
#pragma unroll
      for (int mi = 0; mi < 2; ++mi)
#pragma unroll
        for (int i = 0; i < 16; ++i) {
          const int t = m0 + wm * 64 + mi * 32 + (i & 3) + 8 * (i >> 2) + 4 * hi;
          const float gte = acc[mi][0][i], up = acc[mi][1][i];
          ACT[(size_t)t * DFF + cb] = f2bf(gte * sigmoidf_(gte) * up);
        }
    }
    }
    xcd_barrier(xb);
    {
      char* ws = launder(ws0);
      DECL_PTRS
      const int tid = lv(threadIdx.x), lane = tid & 63, w = tid >> 6, wm = w >> 1, wn = w & 1, f = lane & 31, hi = lane >> 5;
      const int gtid = blockIdx.x * 256 + tid, gthreads = ls(G) * 256;
      (void)wm; (void)wn; (void)f; (void)hi; (void)gtid; (void)gthreads; (void)w;
    TILE_LOOP(8) {
      int mt, nt;
      tile_map(q_, 8, xcdmap, mt, nt);
      const int m0 = mt * 128, n0 = nt * 128;
      f32x16 acc[2][2];
      zero_acc<2>(acc);
      mma_block<2>(ACT + (size_t)m0 * DFF, DFF, Wb + W_DOWN + (size_t)n0 * DFF, DFF, DFF, acc, smem);
#pragma unroll
      for (int mi = 0; mi < 2; ++mi)
#pragma unroll
        for (int ni = 0; ni < 2; ++ni)
#pragma unroll
          for (int i = 0; i < 16; ++i) {
            const size_t idx = (size_t)(m0 + wm * 64 + mi * 32 + (i & 3) + 8 * (i >> 2) + 4 * hi) * DM + n0 + wn * 64 + ni * 32 + f;
            xo[idx] += acc[mi][ni][i];
            if ((i & 15) == 15) asm volatile("" ::: "memory");
          }
    }
    }
    xcd_barrier(xb);
    {
      char* ws = launder(ws0);
      DECL_PTRS
      const int tid = lv(threadIdx.x), lane = tid & 63, w = tid >> 6, wm = w >> 1, wn = w & 1, f = lane & 31, hi = lane >> 5;
      const int gtid = blockIdx.x * 256 + tid, gthreads = ls(G) * 256;
      (void)wm; (void)wn; (void)f; (void)hi; (void)gtid; (void)gthreads; (void)w;
    norm_rows_f32(xo, gptr(P.in[25]) + layer * DM, H);
    }
    xcd_barrier(xb);
    {
      char* ws = launder(ws0);
      DECL_PTRS
      const int tid = lv(threadIdx.x), lane = tid & 63, w = tid >> 6, wm = w >> 1, wn = w & 1, f = lane & 31, hi = lane >> 5;
      const int gtid = blockIdx.x * 256 + tid, gthreads = ls(G) * 256;
      (void)wm; (void)wn; (void)f; (void)hi; (void)gtid; (void)gthreads; (void)w;
    TILE_LOOP(16) {
      int mt, nt;
      tile_map(q_, 16, xcdmap, mt, nt);
      const int m0 = mt * 128, n0 = nt * 64;
      f32x16 acc[2][1];
      zero_acc<1>(acc);
      mma_block<1>(PB + (size_t)m0 * 256, 256, Wb + W_PLEP + (size_t)n0 * 256, 256, 256, acc, smem);
      uint32_t pk[2][8];
#pragma unroll
      for (int mi = 0; mi < 2; ++mi)
#pragma unroll
        for (int i = 0; i < 8; ++i) pk[mi][i] = pack2(acc[mi][0][2 * i], acc[mi][0][2 * i + 1]);
      zero_acc<1>(acc);
      mma_block<1>(H + (size_t)m0 * DM, DM, Wb + W_PLEG + (size_t)n0 * 1024, 1024, 1024, acc, smem);
#pragma unroll
      for (int mi = 0; mi < 2; ++mi)
#pragma unroll
        for (int i = 0; i < 16; ++i) {
          const size_t idx = (size_t)(m0 + wm * 64 + mi * 32 + (i & 3) + 8 * (i >> 2) + 4 * hi) * DM + n0 + wn * 32 + f;
          const uint32_t pv = pk[mi][i >> 1];
          const float pj = (i & 1) ? bfhi(pv) : bflo(pv);
          xo[idx] += sigmoidf_(acc[mi][0][i]) * pj;
          if ((i & 15) == 15) asm volatile("" ::: "memory");
        }
    }
    }
    xcd_barrier(xb);
  }
  {
    const float* gain = gptr(P.in[28]);
    const int tid = lv(threadIdx.x), lane = tid & 63, w = tid >> 6;
    for (int row = blockIdx.x * 4 + w; row < T_; row += G * 4) {
      float* xp = xo + (size_t)row * DM;
      float4 v[4];
      float ss = 0.f;
#pragma unroll
      for (int i = 0; i < 4; ++i) {
        v[i] = *(const float4*)(xp + i * 256 + lane * 4);
        ss += v[i].x * v[i].x + v[i].y * v[i].y + v[i].z * v[i].z + v[i].w * v[i].w;
      }
      ss = wave_sum(ss);
      const float rs = rsqrtf(ss * (1.f / DM) + 1e-6f);
#pragma unroll
      for (int i = 0; i < 4; ++i) {
        const float4 g = *(const float4*)(gain + i * 256 + lane * 4);
        float4 o;
        o.x = v[i].x * rs * g.x; o.y = v[i].y * rs * g.y; o.z = v[i].z * rs * g.z; o.w = v[i].w * rs * g.w;
        *(float4*)(xp + i * 256 + lane * 4) = o;
      }
    }
  }
}

extern "C" void kernel_launch(void* const* d_in, const int* in_sizes, int n_in, void* d_out, int out_size, void* d_ws,
                              size_t ws_size, hipStream_t stream) {
  static int grid_blocks = 0;
  if (!grid_blocks) {
    int dev = 0, cus = 0, per_cu = 0;
    hipGetDevice(&dev);
    hipDeviceGetAttribute(&cus, hipDeviceAttributeMultiprocessorCount, dev);
    hipOccupancyMaxActiveBlocksPerMultiprocessor(&per_cu, mega, 256, 0);
    if (per_cu > 2) per_cu = 2;
    if (per_cu < 1) per_cu = 1;
    grid_blocks = cus * per_cu;
  }
  if (ws_size < WS_NEED) {
    fprintf(stderr, "workspace too small: %zu < %zu\n", ws_size, (size_t)WS_NEED);
    return;
  }
  hipMemsetAsync((char*)d_ws + OFF_BAR, 0, XCD_BAR_WORDS * sizeof(unsigned), stream);
  Params p{};
  for (int i = 0; i < 29; ++i) p.in[i] = (const float*)d_in[i];
  p.out = (float*)d_out;
  p.ws = (char*)d_ws;
  void* args[] = {&p};
  hipError_t e = hipLaunchCooperativeKernel((void*)mega, dim3(grid_blocks), dim3(256), args, 0, stream);
  if (e != hipSuccess) fprintf(stderr, "cooperative launch failed: %s (grid %d)\n", hipGetErrorString(e), grid_blocks);
}
```

```cpp
#include <hip/hip_runtime.h>
#include <hip/hip_cooperative_groups.h>
#include <stdint.h>
#include <stdio.h>
namespace cg = cooperative_groups;

typedef unsigned short bf16_t;
typedef __attribute__((ext_vector_type(8))) short bf16x8;
typedef __attribute__((ext_vector_type(4))) float f32x4;
typedef __attribute__((ext_vector_type(16))) float f32x16;
typedef __attribute__((ext_vector_type(4))) unsigned u32x4;
#define DI __device__ __forceinline__
#define GAS __attribute__((address_space(1)))
DI char* launder(char* p) {
  unsigned long long v = (unsigned long long)p;
  asm volatile("" : "+s"(v));
  return (char*)(GAS char*)v;
}
template <class T>
DI T* gptr(T* p) {
  return (T*)(GAS T*)(unsigned long long)p;
}

constexpr int S_ = 8192, T_ = 16384, DM = 1024, DFF = 2816;
constexpr size_t MiB = 1ull << 20;
constexpr size_t OFF_W = 0, OFF_H = 40 * MiB, OFF_Z = 72 * MiB, OFF_M = 154 * MiB, OFF_X = 218 * MiB;
constexpr size_t OFF_BAR = 240 * MiB;
constexpr size_t WS_NEED = 241 * MiB;
constexpr size_t W_IN = 0;
constexpr size_t W_1K = W_IN + 2688ull * 1024;
constexpr size_t W_1V = W_1K + 256ull * 2048;
constexpr size_t W_2K = W_1V + 256ull * 2048;
constexpr size_t W_2V = W_2K + 128ull * 256;
constexpr size_t W_QUP = W_2V + 128ull * 256;
constexpr size_t W_KVUP = W_QUP + 768ull * 256;
constexpr size_t W_G = W_KVUP + 1024ull * 256;
constexpr size_t W_PA = W_G + 3072ull * 1024;
constexpr size_t W_PB = W_PA + 1024ull * 512;
constexpr size_t W_PC = W_PB + 1024ull * 512;
constexpr size_t W_OUT = W_PC + 1024ull * 512;
constexpr size_t W_GU = W_OUT + 1024ull * 1024;
constexpr size_t W_DOWN = W_GU + 5632ull * 1024;
constexpr size_t W_PLEP = W_DOWN + 1024ull * 2816;
constexpr size_t W_PLEG = W_PLEP + 1024ull * 256;
constexpr size_t W_END = W_PLEG + 1024ull * 1024;
static_assert(W_END * 2 <= 40 * MiB, "weights region");

constexpr float LOG2E = 1.4426950408889634f;
constexpr int SMEM_BYTES = 73728;
constexpr int L_KB = 0, L_VB = 13312, L_IMP = 22528, L_VALS = L_IMP + 2 * 32 * 132 * 4, L_SELM = L_VALS + 32 * 128 * 4, L_UNI = L_SELM + 512;
static_assert(L_UNI + 16 <= SMEM_BYTES, "lds");

struct Params {
  const float* in[29];
  float* out;
  char* ws;
};

typedef __attribute__((ext_vector_type(2))) __bf16 bf2_t;
typedef __attribute__((ext_vector_type(2))) float f2_t;
DI uint32_t pack2(float a, float b) {
  f2_t v = {a, b};
  return __builtin_bit_cast(uint32_t, __builtin_convertvector(v, bf2_t));
}
DI bf16_t f2bf(float x) { return (bf16_t)(pack2(x, 0.f) & 0xffffu); }
DI float bflo(uint32_t v) { return __uint_as_float(v << 16); }
DI float bfhi(uint32_t v) { return __uint_as_float(v & 0xffff0000u); }
DI float sigmoidf_(float x) { return 1.f / (1.f + __expf(-x)); }
DI int lv(int x) {
  asm volatile("" : "+v"(x));
  return x;
}
DI int ls(int x) {
  asm volatile("" : "+s"(x));
  return x;
}
DI float lz0() {
  float z = 0.f;
  asm volatile("" : "+v"(z));
  return z;
}
DI float x16(float v) {
  auto r = __builtin_amdgcn_permlane16_swap(__float_as_uint(v), __float_as_uint(v), false, false);
  return __uint_as_float(((threadIdx.x >> 4) & 1) ? r[0] : r[1]);
}
DI float x32(float v) {
  auto r = __builtin_amdgcn_permlane32_swap(__float_as_uint(v), __float_as_uint(v), false, false);
  return __uint_as_float(((threadIdx.x >> 5) & 1) ? r[0] : r[1]);
}
DI float max16_32(float v) {
  auto r = __builtin_amdgcn_permlane16_swap(__float_as_uint(v), __float_as_uint(v), false, false);
  v = fmaxf(__uint_as_float(r[0]), __uint_as_float(r[1]));
  auto q = __builtin_amdgcn_permlane32_swap(__float_as_uint(v), __float_as_uint(v), false, false);
  return fmaxf(__uint_as_float(q[0]), __uint_as_float(q[1]));
}
DI float sum16_32(float v) {
  auto r = __builtin_amdgcn_permlane16_swap(__float_as_uint(v), __float_as_uint(v), false, false);
  v = __uint_as_float(r[0]) + __uint_as_float(r[1]);
  auto q = __builtin_amdgcn_permlane32_swap(__float_as_uint(v), __float_as_uint(v), false, false);
  return __uint_as_float(q[0]) + __uint_as_float(q[1]);
}
DI float wave_sum(float v) {
  for (int o = 32; o > 0; o >>= 1) v += __shfl_xor(v, o);
  return v;
}


__device__ const float INVF64[32] = {1.f, 0.749894261f, 0.562341332f, 0.421696514f, 0.316227764f, 0.237137377f, 0.177827939f, 0.133352131f,
    0.100000001f, 0.0749894157f, 0.0562341325f, 0.0421696529f, 0.0316227749f, 0.0237137377f, 0.0177827943f, 0.0133352149f,
    0.00999999978f, 0.00749894185f, 0.00562341325f, 0.00421696482f, 0.00316227763f, 0.00237137359f, 0.00177827943f, 0.00133352145f,
    0.00100000005f, 0.000749894243f, 0.000562341302f, 0.000421696517f, 0.000316227757f, 0.00023713737f, 0.00017782794f, 0.00013335215f};
DI void sincos_acc(float ang, float& c, float& s) {
  const double x = (double)ang;
  const double kd = rint(x * 0.6366197723675814);
  double r = fma(-kd, 1.5707963267948966, x);
  r = fma(-kd, 6.123233995736766e-17, r);
  const int k = (int)kd;
  const double r2 = r * r;
  const double sp = r * (1.0 + r2 * (-1.0 / 6 + r2 * (1.0 / 120 + r2 * (-1.0 / 5040 + r2 * (1.0 / 362880 + r2 * (-1.0 / 39916800 + r2 * (1.0 / 6227020800.0)))))));
  const double cp = 1.0 + r2 * (-0.5 + r2 * (1.0 / 24 + r2 * (-1.0 / 720 + r2 * (1.0 / 40320 + r2 * (-1.0 / 3628800 + r2 * (1.0 / 479001600.0))))));
  const int qd = k & 3;
  const double sv = (qd == 0) ? sp : (qd == 1) ? cp : (qd == 2) ? -sp : -cp;
  const double cv = (qd == 0) ? cp : (qd == 1) ? -sp : (qd == 2) ? -cp : sp;
  s = (float)sv;
  c = (float)cv;
}

template <int NT, bool LEAN = false>
DI void mma_block(const bf16_t* __restrict__ A, int lda, const bf16_t* __restrict__ B, int ldb, int K,
                  f32x16 (&acc)[2][NT], char* smem) {
  constexpr int ASZ = 128 * 144, BSZ = 64 * NT * 144;
  char* As = smem;
  char* Bs = smem + 2 * ASZ;
  const int tid = lv(threadIdx.x), lane = tid & 63, w = tid >> 6, wm = w >> 1, wn = w & 1;
  const int crow = tid >> 3, ccol = tid & 7;
  u32x4 ra0[4], rb0[2 * NT], ra1[4], rb1[2 * NT];
  const unsigned aoff = (unsigned)(crow * lda + ccol * 8) * 2u, astep = (unsigned)lda * 64u;
  const unsigned boff = (unsigned)(crow * ldb + ccol * 8) * 2u, bstep = (unsigned)ldb * 64u;
  const char* Ac = (const char*)A;
  const char* Bc = (const char*)B;
  const int nk = K >> 6;
  const int soff = crow * 144 + ccol * 16;
#define MMA_GLOAD(ra, rb, k0)                                                                        \
  {                                                                                                  \
    _Pragma("unroll") for (int i = 0; i < 4; ++i) ra[i] = *(const u32x4*)(Ac + (size_t)(k0) * 2 + (aoff + i * astep)); \
    _Pragma("unroll") for (int i = 0; i < 2 * NT; ++i) rb[i] = *(const u32x4*)(Bc + (size_t)(k0) * 2 + (boff + i * bstep)); \
  }
#define MMA_SSTORE(ra, rb, buf)                                                                      \
  {                                                                                                  \
    _Pragma("unroll") for (int i = 0; i < 4; ++i) *(u32x4*)(As + (buf) * ASZ + soff + 32 * i * 144) = ra[i]; \
    _Pragma("unroll") for (int i = 0; i < 2 * NT; ++i) *(u32x4*)(Bs + (buf) * BSZ + soff + 32 * i * 144) = rb[i]; \
  }
#define MMA_RDFRAG(buf, ks, fa, fb)                                                                  \
  {                                                                                                  \
    _Pragma("unroll") for (int mi = 0; mi < 2; ++mi) fa[mi] = *(const bf16x8*)(As + (buf) * ASZ + arow + mi * 32 * 144 + (ks) * 32); \
    _Pragma("unroll") for (int ni = 0; ni < NT; ++ni) fb[ni] = *(const bf16x8*)(Bs + (buf) * BSZ + brow + ni * 32 * 144 + (ks) * 32); \
  }
#define MMA_DO(fa, fb)                                                                               \
  {                                                                                                  \
    _Pragma("unroll") for (int mi = 0; mi < 2; ++mi)                                                 \
      _Pragma("unroll") for (int ni = 0; ni < NT; ++ni)                                              \
        acc[mi][ni] = __builtin_amdgcn_mfma_f32_32x32x16_bf16(fa[mi], fb[ni], acc[mi][ni], 0, 0, 0); \
  }
#define MMA_SSTORE_A(ra, buf)                                                                        \
  { _Pragma("unroll") for (int i = 0; i < 4; ++i) *(u32x4*)(As + (buf) * ASZ + soff + 32 * i * 144) = ra[i]; }
#define MMA_SSTORE_B(rb, buf)                                                                        \
  { _Pragma("unroll") for (int i = 0; i < 2 * NT; ++i) *(u32x4*)(Bs + (buf) * BSZ + soff + 32 * i * 144) = rb[i]; }
#define MMA_STEP(buf, sra, srb, dostore, lra, lrb, doload, lk0)                                      \
  {                                                                                                  \
    bf16x8 fa0[2], fb0[NT], fa1[2], fb1[NT];                                                         \
    MMA_RDFRAG(buf, 0, fa0, fb0);                                                                    \
    MMA_RDFRAG(buf, 1, fa1, fb1);                                                                    \
    MMA_DO(fa0, fb0);                                                                                \
    if (doload) MMA_GLOAD(lra, lrb, lk0);                                                            \
    MMA_RDFRAG(buf, 2, fa0, fb0);                                                                    \
    if (dostore) MMA_SSTORE_A(sra, (buf) ^ 1);                                                       \
    MMA_DO(fa1, fb1);                                                                                \
    MMA_RDFRAG(buf, 3, fa1, fb1);                                                                    \
    if (dostore) MMA_SSTORE_B(srb, (buf) ^ 1);                                                       \
    MMA_DO(fa0, fb0);                                                                                \
    MMA_DO(fa1, fb1);                                                                                \
    __builtin_amdgcn_sched_group_barrier(0x100, 2 * (2 + NT), 0);                                    \
    __builtin_amdgcn_sched_group_barrier(0x008, 2 * NT, 0);                                          \
    __builtin_amdgcn_sched_group_barrier(0x020, 4 + 2 * NT, 0);                                      \
    __builtin_amdgcn_sched_group_barrier(0x100, 2 + NT, 0);                                          \
    __builtin_amdgcn_sched_group_barrier(0x200, 4, 0);                                               \
    __builtin_amdgcn_sched_group_barrier(0x008, 2 * NT, 0);                                          \
    __builtin_amdgcn_sched_group_barrier(0x100, 2 + NT, 0);                                          \
    __builtin_amdgcn_sched_group_barrier(0x200, 2 * NT, 0);                                          \
    __builtin_amdgcn_sched_group_barrier(0x008, 2 * NT, 0);                                          \
    __builtin_amdgcn_sched_group_barrier(0x008, 2 * NT, 0);                                          \
  }
#define MMA_STEP_LEAN(buf, sra, srb, dostore, lra, lrb, doload, lk0)                                 \
  {                                                                                                  \
    bf16x8 fa0[2], fb0[NT];                                                                          \
    if (doload) MMA_GLOAD(lra, lrb, lk0);                                                            \
    MMA_RDFRAG(buf, 0, fa0, fb0);                                                                    \
    MMA_DO(fa0, fb0);                                                                                \
    MMA_RDFRAG(buf, 1, fa0, fb0);                                                                    \
    MMA_DO(fa0, fb0);                                                                                \
    if (dostore) MMA_SSTORE_A(sra, (buf) ^ 1);                                                       \
    MMA_RDFRAG(buf, 2, fa0, fb0);                                                                    \
    MMA_DO(fa0, fb0);                                                                                \
    if (dostore) MMA_SSTORE_B(srb, (buf) ^ 1);                                                       \
    MMA_RDFRAG(buf, 3, fa0, fb0);                                                                    \
    MMA_DO(fa0, fb0);                                                                                \
  }
  __syncthreads();
  MMA_GLOAD(ra0, rb0, 0);
  MMA_GLOAD(ra1, rb1, 64);
  MMA_SSTORE(ra0, rb0, 0);
  __syncthreads();
  const int arow = (wm * 64 + (lane & 31)) * 144 + (lane >> 5) * 16;
  const int brow = (wn * 32 * NT + (lane & 31)) * 144 + (lane >> 5) * 16;
  for (int kt = 0; kt < nk; kt += 2) {
    if (LEAN) { MMA_STEP_LEAN(0, ra1, rb1, true, ra0, rb0, (kt + 2 < nk), (kt + 2) << 6); }
    else { MMA_STEP(0, ra1, rb1, true, ra0, rb0, (kt + 2 < nk), (kt + 2) << 6); }
    __syncthreads();
    if (LEAN) { MMA_STEP_LEAN(1, ra0, rb0, (kt + 2 < nk), ra1, rb1, (kt + 3 < nk), (kt + 3) << 6); }
    else { MMA_STEP(1, ra0, rb0, (kt + 2 < nk), ra1, rb1, (kt + 3 < nk), (kt + 3) << 6); }
    __syncthreads();
  }
#undef MMA_RDFRAG
#undef MMA_DO
#undef MMA_SSTORE_A
#undef MMA_SSTORE_B
#undef MMA_STEP
#undef MMA_STEP_LEAN
#undef MMA_GLOAD
#undef MMA_SSTORE
#undef MMA_COMPUTE
}

template <int NT>
DI void zero_acc(f32x16 (&acc)[2][NT]) {
  const float z_ = lz0();
#pragma unroll
  for (int mi = 0; mi < 2; ++mi)
#pragma unroll
    for (int ni = 0; ni < NT; ++ni)
#pragma unroll
      for (int i = 0; i < 16; ++i) acc[mi][ni][i] = z_;
}

template <bool FFN = false>
DI void conv_seg(const float* __restrict__ src, int ldN, int c0, int nc, int K, bf16_t* __restrict__ dst, int r0,
                 int& base, char* smem) {
  float* tile = (float*)smem;
  const int tid = lv(threadIdx.x), G = gridDim.x;
  const int nkt = K >> 6, nnt = (nc + 63) >> 6, total = nkt * nnt;
  int first = ((int)blockIdx.x - (base % G) + G) % G;
  base += total;
  const int r = tid >> 4, c4 = (tid & 15) * 4;
  f32x4 v0, v1, v2, v3;
#define CONV_PREFETCH(tt)                                                                            \
  {                                                                                                  \
    const int kt_ = (tt) % nkt, nt_ = (tt) / nkt;                                                    \
    const int n_ = nt_ * 64 + c4;                                                                    \
    const float* sp_ = src + (size_t)(kt_ * 64 + r) * ldN + c0 + n_;                                 \
    const float zz_ = lz0();                                                                         \
    const f32x4 z_ = {zz_, zz_, zz_, zz_};                                                           \
    v0 = v1 = v2 = v3 = z_;                                                                          \
    if (n_ < nc) {                                                                                   \
      v0 = *(const f32x4*)(sp_);                                                                     \
      v1 = *(const f32x4*)(sp_ + (size_t)16 * ldN);                                                  \
      v2 = *(const f32x4*)(sp_ + (size_t)32 * ldN);                                                  \
      v3 = *(const f32x4*)(sp_ + (size_t)48 * ldN);                                                  \
    }                                                                                                \
  }
  if (first < total) CONV_PREFETCH(first);
  for (int t = first; t < total; t += G) {
    const int kt = t % nkt, nt = t / nkt;
    __syncthreads();
    {
      float* tp = tile + r * 65 + c4;
      tp[0] = v0[0]; tp[1] = v0[1]; tp[2] = v0[2]; tp[3] = v0[3];
      tp += 16 * 65;
      tp[0] = v1[0]; tp[1] = v1[1]; tp[2] = v1[2]; tp[3] = v1[3];
      tp += 16 * 65;
      tp[0] = v2[0]; tp[1] = v2[1]; tp[2] = v2[2]; tp[3] = v2[3];
      tp += 16 * 65;
      tp[0] = v3[0]; tp[1] = v3[1]; tp[2] = v3[2]; tp[3] = v3[3];
    }
    if (t + G < total) CONV_PREFETCH(t + G);
    __syncthreads();
    {
      const int n = tid >> 2, kq = (tid & 3) * 16;
      if (nt * 64 + n < nc) {
        uint32_t o[8];
#pragma unroll
        for (int i = 0; i < 8; ++i) o[i] = pack2(tile[(kq + 2 * i) * 65 + n], tile[(kq + 2 * i + 1) * 65 + n]);
        const int nn = nt * 64 + n;
        const int drow = FFN ? (r0 + (nn >> 5) * 64 + (nn & 31)) : (r0 + nn);
        uint4* dp = (uint4*)(dst + (size_t)drow * K + kt * 64 + kq);
        dp[0] = make_uint4(o[0], o[1], o[2], o[3]);
        dp[1] = make_uint4(o[4], o[5], o[6], o[7]);
      }
    }
  }
}

#undef CONV_PREFETCH
DI void norm_rows_f32(const float* __restrict__ x, const float* __restrict__ gain, bf16_t* __restrict__ dst) {
  const int tid_ = lv(threadIdx.x), lane = tid_ & 63, w = tid_ >> 6;
  for (int row = blockIdx.x * 4 + w; row < T_; row += gridDim.x * 4) {
    const float* xp = x + (size_t)row * DM;
    float4 v[4];
    float ss = 0.f;
#pragma unroll
    for (int i = 0; i < 4; ++i) {
      v[i] = *(const float4*)(xp + i * 256 + lane * 4);
      ss += v[i].x * v[i].x + v[i].y * v[i].y + v[i].z * v[i].z + v[i].w * v[i].w;
    }
    ss = wave_sum(ss);
    const float rs = rsqrtf(ss * (1.f / DM) + 1e-6f);
#pragma unroll
    for (int i = 0; i < 4; ++i) {
      const float4 g = *(const float4*)(gain + i * 256 + lane * 4);
      uint2 o;
      o.x = pack2(v[i].x * rs * g.x, v[i].y * rs * g.y);
      o.y = pack2(v[i].z * rs * g.z, v[i].w * rs * g.w);
      *(uint2*)(dst + (size_t)row * DM + i * 256 + lane * 4) = o;
    }
  }
}

#define KVREGS(name, DQK) u32x4 name##k[(DQK) / 32], name##v[2]

template <int DQK, bool LOADV>
DI void kv_gload_(u32x4 (&rk)[DQK / 32], u32x4 (&rv)[2], const bf16_t* __restrict__ Kt, const bf16_t* __restrict__ Vt, int Sv) {
  const int tid = lv(threadIdx.x);
#pragma unroll
  for (int i = 0; i < DQK / 32; ++i) rk[i] = *(const u32x4*)((const char*)Kt + (size_t)(tid + 256 * i) * 16);
  if (LOADV) {
#pragma unroll
    for (int i = 0; i < 2; ++i) {
      const int c = tid + 256 * i, d = c >> 3, cc = c & 7;
      rv[i] = *(const u32x4*)(Vt + (size_t)d * Sv + cc * 8);
    }
  }
}
template <int DQK, bool LOADV>
DI void kv_sstore_(const u32x4 (&rk)[DQK / 32], const u32x4 (&rv)[2], char* smem) {
  constexpr int CPR = DQK / 8, KSTR = DQK * 2 + 16;
  const int tid = lv(threadIdx.x);
#pragma unroll
  for (int i = 0; i < DQK / 32; ++i) {
    const int c = tid + 256 * i, k = c / CPR, cc = c % CPR;
    const int rho = (k & 32) | (((k >> 2) & 1) << 4) | (((k >> 3) & 3) << 2) | (k & 3);
    *(u32x4*)(smem + L_KB + rho * KSTR + cc * 16) = rk[i];
  }
  if (LOADV) {
#pragma unroll
    for (int i = 0; i < 2; ++i) {
      const int c = tid + 256 * i, d = c >> 3, cc = c & 7;
      *(u32x4*)(smem + L_VB + d * 144 + cc * 16) = rv[i];
    }
  }
}
#define kv_gload(DQK, LV, rg, K, V, SV) kv_gload_<DQK, LV>(rg##k, rg##v, K, V, SV)
#define kv_sstore(DQK, LV, rg, sm) kv_sstore_<DQK, LV>(rg##k, rg##v, sm)

template <int NQ, int KS, int MODE, int MASKMODE>
DI void attn_tile(const char* smem, const bf16x8 (&Qf)[NQ][KS], f32x4 (&O)[NQ][4], float (&m)[NQ], float (&l)[NQ],
                  float sc2, const int (&kmax)[NQ], const int (&kmin)[NQ], float* improw, int Jbase) {
  constexpr int KSTR = KS * 64 + 16;
  const int lane = lv(threadIdx.x) & 63, q = lane & 15, g4 = lane >> 4;
  const char* Kb = smem + L_KB + q * KSTR + g4 * 16;
  const char* Vb = smem + L_VB + q * 144 + g4 * 16;
  f32x4 Sa[NQ][4];
#pragma unroll
  for (int c = 0; c < NQ; ++c)
#pragma unroll
    for (int u = 0; u < 4; ++u) Sa[c][u] = f32x4{0.f, 0.f, 0.f, 0.f};
#pragma unroll
  for (int u = 0; u < 4; ++u)
#pragma unroll
    for (int ks = 0; ks < KS; ++ks) {
      const bf16x8 a = *(const bf16x8*)(Kb + (16 * u) * KSTR + ks * 64);
#pragma unroll
      for (int c = 0; c < NQ; ++c) Sa[c][u] = __builtin_amdgcn_mfma_f32_16x16x32_bf16(a, Qf[c][ks], Sa[c][u], 0, 0, 0);
    }
  bf16x8 Pf[NQ][2];
  float ia[4] = {0.f, 0.f, 0.f, 0.f}, ib[4] = {0.f, 0.f, 0.f, 0.f};
#pragma unroll
  for (int c = 0; c < NQ; ++c) {
    float sv[16];
    const int kx = kmax[c] - 8 * g4, kn = kmin[c] - 8 * g4;
#pragma unroll
    for (int u = 0; u < 4; ++u)
#pragma unroll
      for (int i = 0; i < 4; ++i) {
        const int kc = 32 * (u >> 1) + 4 * (u & 1) + i;
        float v = Sa[c][u][i];
        if (MASKMODE >= 1) v = (kc <= kx) ? v : -1e30f;
        if (MASKMODE == 2) v = (kc >= kn) ? v : -1e30f;
        sv[4 * u + i] = v;
      }
    float p[16];
    if (MODE == 2) {
      const float msc = m[c] * sc2;
#pragma unroll
      for (int e = 0; e < 16; ++e) p[e] = __builtin_amdgcn_exp2f(fmaf(sv[e], sc2, -msc)) * l[c];
#pragma unroll
      for (int u = 0; u < 4; ++u) {
        ia[u] += p[4 * u] + p[4 * u + 1] + p[4 * u + 2] + 0.5f * p[4 * u + 3];
        ib[u] += 0.5f * p[4 * u + 3];
      }
    } else {
      float msc = m[c] * sc2;
      float rs = 0.f;
#pragma unroll
      for (int e = 0; e < 16; ++e) {
        p[e] = __builtin_amdgcn_exp2f(fmaf(sv[e], sc2, -msc));
        rs += p[e];
      }
      float mx = sv[0];
#pragma unroll
      for (int e = 1; e < 16; ++e) mx = fmaxf(mx, sv[e]);
      if (__builtin_amdgcn_ballot_w64((mx - m[c]) * sc2 > 5.770780163555854f) != 0ull) {
        mx = max16_32(mx);
        const float mn = fmaxf(m[c], mx);
        const float alpha = __builtin_amdgcn_exp2f((m[c] - mn) * sc2);
        m[c] = mn;
        l[c] *= alpha;
        if (MODE == 0) {
#pragma unroll
          for (int dt = 0; dt < 4; ++dt) O[c][dt] *= alpha;
        }
        msc = mn * sc2;
        rs = 0.f;
#pragma unroll
        for (int e = 0; e < 16; ++e) {
          p[e] = __builtin_amdgcn_exp2f(fmaf(sv[e], sc2, -msc));
          rs += p[e];
        }
      }
      l[c] += rs;
    }
    if (MODE != 1) {
#pragma unroll
      for (int hf = 0; hf < 2; ++hf) {
        uint32_t pk[4];
#pragma unroll
        for (int j = 0; j < 4; ++j) pk[j] = pack2(p[8 * hf + 2 * j], p[8 * hf + 2 * j + 1]);
        Pf[c][hf] = __builtin_bit_cast(bf16x8, u32x4{pk[0], pk[1], pk[2], pk[3]});
      }
    }
  }
  if (MODE == 2) {
#pragma unroll
    for (int hf = 0; hf < 2; ++hf) {
      const int J = Jbase + 8 * hf + 2 * g4;
      improw[J] += ia[2 * hf];
      improw[J + 1] += ia[2 * hf + 1];
      __builtin_amdgcn_fence(__ATOMIC_SEQ_CST, "wavefront");
      improw[J + 1] += ib[2 * hf];
      improw[J + 2] += ib[2 * hf + 1];
      __builtin_amdgcn_fence(__ATOMIC_SEQ_CST, "wavefront");
    }
  }
  if (MODE != 1) {
#pragma unroll
    for (int hf = 0; hf < 2; ++hf)
#pragma unroll
      for (int dt = 0; dt < 4; ++dt) {
        const bf16x8 a = *(const bf16x8*)(Vb + dt * 16 * 144 + hf * 64);
#pragma unroll
        for (int c = 0; c < NQ; ++c) O[c][dt] = __builtin_amdgcn_mfma_f32_16x16x32_bf16(a, Pf[c][hf], O[c][dt], 0, 0, 0);
      }
  }
}

template <int NQ>
DI void attn_finish(f32x4 (&O)[NQ][4], float (&l)[NQ]) {
#pragma unroll
  for (int c = 0; c < NQ; ++c) {
    const float t = sum16_32(l[c]);
    l[c] = t > 0.f ? 1.f / t : 0.f;
  }
}

DI void nsa_item(const Params& P, char* ws, int b, int g, int ch, char* smem) {
  bf16_t* AQ = (bf16_t*)(ws + OFF_Z);
  const bf16_t* AKS = (const bf16_t*)(ws + OFF_Z + 24 * MiB);
  const bf16_t* AVST = (const bf16_t*)(ws + OFF_Z + 28 * MiB);
  const bf16_t* AKW = (const bf16_t*)(ws + OFF_Z + 32 * MiB);
  const bf16_t* AVWT = (const bf16_t*)(ws + OFF_Z + 36 * MiB);
  const float* AG = (const float*)(ws + OFF_Z + 80 * MiB);
  const bf16_t* KCMP = (const bf16_t*)(ws + OFF_X + 8 * MiB);
  const bf16_t* VCMPT = (const bf16_t*)(ws + OFF_X + 8 * MiB + 256 * 1024);
  const int tid = lv(threadIdx.x), lane = tid & 63, w = tid >> 6, q = lane & 15, g4 = lane >> 4;
  const int sub = w & 1, hp = w >> 1;
  const int t0 = ch * 32, tq = t0 + 16 * sub + q;
  const size_t tokrow = (size_t)b * S_ + tq;
  const int bg = b * 2 + g;
  const int h0 = g * 4 + 2 * hp;
  bf16x8 Qf[2][2];
#pragma unroll
  for (int c = 0; c < 2; ++c)
#pragma unroll
    for (int ks = 0; ks < 2; ++ks) Qf[c][ks] = *(const bf16x8*)(AQ + (tokrow * 8 + h0 + c) * 64 + ks * 32 + g4 * 8);
  const float* gap = AG + tokrow * 24 + h0 * 3;
  float* imp = (float*)(smem + L_IMP);
  unsigned short* selm = (unsigned short*)(smem + L_SELM);
  unsigned* uni = (unsigned*)(smem + L_UNI);
  __syncthreads();
  for (int i = tid; i < 2 * 32 * 132; i += 256) imp[i] = 0.f;
  if (tid < 4) uni[tid] = 0u;
  const float sc2 = 0.125f * LOG2E;
  const bf16_t* Kc = KCMP + (size_t)bg * 512 * 64;
  const bf16_t* Vc = VCMPT + (size_t)bg * 64 * 512;
  const int nct = ((t0 >> 4) + 1 + 63) >> 6;
  float m[2] = {-1e28f, -1e28f}, l[2] = {0.f, 0.f};
  f32x4 O[2][4];
  f32x4 Ot[2][4];
#pragma unroll
  for (int c = 0; c < 2; ++c)
#pragma unroll
    for (int dt = 0; dt < 4; ++dt) { const float z_ = lz0(); O[c][dt] = f32x4{z_, z_, z_, z_}; }
  KVREGS(rg, 64);
  kv_gload(64, false, rg, Kc, Vc, 512);
  for (int tile = 0; tile < nct; ++tile) {
    __syncthreads();
    kv_sstore(64, false, rg, smem);
    __syncthreads();
    if (tile + 1 < nct) kv_gload(64, false, rg, Kc + (size_t)(tile + 1) * 64 * 64, Vc, 512);
    const int kx_ = ((tq - 31) >> 4) - 64 * tile;
    const int kmx[2] = {kx_, kx_}, kmn[2] = {0, 0};
    attn_tile<2, 2, 1, 1>(smem, Qf, O, m, l, sc2, kmx, kmn, nullptr, 0);
  }
  attn_finish<2>(O, l);
  kv_gload(64, true, rg, Kc, Vc, 512);
  float* improw = imp + (hp * 32 + 16 * sub + q) * 132;
  for (int tile = 0; tile < nct; ++tile) {
    __syncthreads();
    kv_sstore(64, true, rg, smem);
    __syncthreads();
    if (tile + 1 < nct) kv_gload(64, true, rg, Kc + (size_t)(tile + 1) * 64 * 64, Vc + (tile + 1) * 64, 512);
    const int kx_ = ((tq - 31) >> 4) - 64 * tile;
    const int kmx[2] = {kx_, kx_}, kmn[2] = {0, 0};
    attn_tile<2, 2, 2, 1>(smem, Qf, O, m, l, sc2, kmx, kmn, improw, tile * 16);
  }
#pragma unroll
  for (int c = 0; c < 2; ++c)
#pragma unroll
    for (int dt = 0; dt < 4; ++dt) Ot[c][dt] = O[c][dt] * gap[c * 3];
  __syncthreads();
  const int cur = t0 >> 6;
  {
    const int tok = tid >> 3, s8 = tid & 7;
    const float* i0 = imp + tok * 132;
    const float* i1 = imp + (32 + tok) * 132;
    unsigned mask16 = 0;
    if (cur < 16) {
#pragma unroll
      for (int jj = 0; jj < 16; ++jj) mask16 |= ((s8 * 16 + jj) <= cur) ? (1u << jj) : 0u;
    } else {
      unsigned long long key[16];
#pragma unroll
      for (int jj = 0; jj < 16; ++jj) {
        const int j = s8 * 16 + jj;
        const float v = (i0[j] + i1[j]) + ((j == 0 || j == cur || j == cur - 1) ? 1e4f : 0.f);
        const unsigned kb = (j <= cur) ? (__float_as_uint(v) + 1u) : 0u;
        key[jj] = ((unsigned long long)kb << 8) | (unsigned long long)(127 - j);
      }
#pragma unroll 1
      for (int r = 0; r < 16; ++r) {
        unsigned long long mx = key[0];
#pragma unroll
        for (int jj = 1; jj < 16; ++jj) mx = key[jj] > mx ? key[jj] : mx;
#pragma unroll
        for (int o = 1; o < 8; o <<= 1) {
          const unsigned long long ot = __shfl_xor(mx, o);
          mx = ot > mx ? ot : mx;
        }
#pragma unroll
        for (int jj = 0; jj < 16; ++jj) {
          const bool hit = key[jj] == mx;
          mask16 |= hit ? (1u << jj) : 0u;
          key[jj] = hit ? 0ull : key[jj];
        }
      }
    }
    selm[tok * 8 + s8] = (unsigned short)mask16;
    if (mask16) atomicOr(&uni[s8 >> 1], mask16 << ((s8 & 1) * 16));
  }
  __syncthreads();
  unsigned mkb[4], un[4];
  {
    const unsigned short* sm = selm + (16 * sub + q) * 8;
#pragma unroll
    for (int i = 0; i < 4; ++i) {
      mkb[i] = (unsigned)sm[2 * i] | ((unsigned)sm[2 * i + 1] << 16);
      un[i] = uni[i];
    }
  }
  {
    const bf16_t* Ks = AKS + (size_t)bg * S_ * 64;
    const bf16_t* Vs = AVST + (size_t)bg * 64 * S_;
    m[0] = m[1] = -1e28f;
    l[0] = l[1] = 0.f;
#pragma unroll
    for (int c = 0; c < 2; ++c)
#pragma unroll
      for (int dt = 0; dt < 4; ++dt) { const float z_ = lz0(); O[c][dt] = f32x4{z_, z_, z_, z_}; }
    auto nextset = [&](int from) {
      for (int j = from; j <= cur; ++j)
        if ((un[j >> 5] >> (j & 31)) & 1u) return j;
      return -1;
    };
    int j = nextset(0);
    if (j >= 0) kv_gload(64, true, rg, Ks + (size_t)j * 64 * 64, Vs + j * 64, S_);
    while (j >= 0) {
      __syncthreads();
      kv_sstore(64, true, rg, smem);
      __syncthreads();
      const int jn = nextset(j + 1);
      if (jn >= 0) kv_gload(64, true, rg, Ks + (size_t)jn * 64 * 64, Vs + jn * 64, S_);
      const bool bit = (mkb[j >> 5] >> (j & 31)) & 1u;
      if (__ballot(bit) != 0ull) {
        const int kx_ = bit ? (tq - 64 * j) : -1;
        const int kmx[2] = {kx_, kx_}, kmn[2] = {0, 0};
        attn_tile<2, 2, 0, 1>(smem, Qf, O, m, l, sc2, kmx, kmn, nullptr, 0);
      }
      j = jn;
    }
    attn_finish<2>(O, l);
#pragma unroll
    for (int c = 0; c < 2; ++c)
#pragma unroll
      for (int dt = 0; dt < 4; ++dt) Ot[c][dt] += O[c][dt] * (l[c] * gap[c * 3 + 1]);
  }
  {
    const bf16_t* Kw = AKW + (size_t)bg * S_ * 64;
    const bf16_t* Vw = AVWT + (size_t)bg * 64 * S_;
    m[0] = m[1] = -1e28f;
    l[0] = l[1] = 0.f;
#pragma unroll
    for (int c = 0; c < 2; ++c)
#pragma unroll
      for (int dt = 0; dt < 4; ++dt) { const float z_ = lz0(); O[c][dt] = f32x4{z_, z_, z_, z_}; }
    int jlo = (t0 - 511) >> 6;
    if (jlo < 0) jlo = 0;
    const int jhi = t0 >> 6;
    kv_gload(64, true, rg, Kw + (size_t)jlo * 64 * 64, Vw + jlo * 64, S_);
    for (int j = jlo; j <= jhi; ++j) {
      __syncthreads();
      kv_sstore(64, true, rg, smem);
      __syncthreads();
      if (j + 1 <= jhi) kv_gload(64, true, rg, Kw + (size_t)(j + 1) * 64 * 64, Vw + (j + 1) * 64, S_);
      const int kx_ = tq - 64 * j, kn_ = tq - 511 - 64 * j;
      const int kmx[2] = {kx_, kx_}, kmn[2] = {kn_, kn_};
      attn_tile<2, 2, 0, 2>(smem, Qf, O, m, l, sc2, kmx, kmn, nullptr, 0);
    }
    attn_finish<2>(O, l);
#pragma unroll
    for (int c = 0; c < 2; ++c)
#pragma unroll
      for (int dt = 0; dt < 4; ++dt) Ot[c][dt] += O[c][dt] * (l[c] * gap[c * 3 + 2]);
  }
#pragma unroll
  for (int c = 0; c < 2; ++c)
#pragma unroll
    for (int dt = 0; dt < 4; ++dt) {
      uint2 o;
      o.x = pack2(Ot[c][dt][0], Ot[c][dt][1]);
      o.y = pack2(Ot[c][dt][2], Ot[c][dt][3]);
      *(uint2*)(AQ + (tokrow * 8 + h0 + c) * 64 + dt * 16 + 4 * g4) = o;
    }
}

DI void swa_item(const Params& P, char* ws, int layer, int b, int g, int ch, char* smem) {
  bf16_t* BQ = (bf16_t*)(ws + OFF_Z + 40 * MiB);
  const bf16_t* BK = (const bf16_t*)(ws + OFF_Z + 56 * MiB);
  const bf16_t* BVT = (const bf16_t*)(ws + OFF_Z + 60 * MiB);
  const float* sinks = gptr(P.in[11]) + layer * 8;
  const int tid = lv(threadIdx.x), lane = tid & 63, w = tid >> 6, q = lane & 15, g4 = lane >> 4;
  const int sub = w & 1, hp = w >> 1;
  const int t0 = ch * 32, tq = t0 + 16 * sub + q;
  const size_t tokrow = (size_t)b * S_ + tq;
  const int bg = b * 2 + g;
  const int h0 = g * 4 + 2 * hp;
  bf16x8 Qf[2][2];
#pragma unroll
  for (int c = 0; c < 2; ++c)
#pragma unroll
    for (int ks = 0; ks < 2; ++ks) Qf[c][ks] = *(const bf16x8*)(BQ + (tokrow * 8 + h0 + c) * 64 + ks * 32 + g4 * 8);
  const float sc2 = 0.125f * LOG2E;
  float m[2], l[2];
  f32x4 O[2][4];
#pragma unroll
  for (int c = 0; c < 2; ++c) {
    m[c] = sinks[h0 + c] * 8.f;
    l[c] = (g4 == 0) ? 1.f : 0.f;
#pragma unroll
    for (int dt = 0; dt < 4; ++dt) { const float z_ = lz0(); O[c][dt] = f32x4{z_, z_, z_, z_}; }
  }
  const bf16_t* Kb = BK + (size_t)bg * S_ * 64;
  const bf16_t* Vb = BVT + (size_t)bg * 64 * S_;
  int jlo = (t0 - 127) >> 6;
  if (jlo < 0) jlo = 0;
  const int jhi = t0 >> 6;
  KVREGS(rg, 64);
  kv_gload(64, true, rg, Kb + (size_t)jlo * 64 * 64, Vb + jlo * 64, S_);
  for (int j = jlo; j <= jhi; ++j) {
    __syncthreads();
    kv_sstore(64, true, rg, smem);
    __syncthreads();
    if (j + 1 <= jhi) kv_gload(64, true, rg, Kb + (size_t)(j + 1) * 64 * 64, Vb + (j + 1) * 64, S_);
    const int kx_ = tq - 64 * j, kn_ = tq - 127 - 64 * j;
    const int kmx[2] = {kx_, kx_}, kmn[2] = {kn_, kn_};
    attn_tile<2, 2, 0, 2>(smem, Qf, O, m, l, sc2, kmx, kmn, nullptr, 0);
  }
  attn_finish<2>(O, l);
#pragma unroll
  for (int c = 0; c < 2; ++c)
#pragma unroll
    for (int dt = 0; dt < 4; ++dt) {
      uint2 o;
      o.x = pack2(O[c][dt][0] * l[c], O[c][dt][1] * l[c]);
      o.y = pack2(O[c][dt][2] * l[c], O[c][dt][3] * l[c]);
      *(uint2*)(BQ + (tokrow * 8 + h0 + c) * 64 + dt * 16 + 4 * g4) = o;
    }
}

DI void mla_item(const Params& P, char* ws, int b, int h, int qb, char* smem) {
  const bf16_t* CQF = (const bf16_t*)(ws + OFF_M);
  const bf16_t* CK = (const bf16_t*)(ws + OFF_M + 24 * MiB);
  const bf16_t* CVT = (const bf16_t*)(ws + OFF_M + 48 * MiB);
  bf16_t* OC = (bf16_t*)(ws + OFF_Z + 64 * MiB);
  const int tid = lv(threadIdx.x), lane = tid & 63, w = tid >> 6, q = lane & 15, g4 = lane >> 4;
  const int t0 = qb * 128;
  int tq[2];
  bf16x8 Qf[2][3];
#pragma unroll
  for (int c = 0; c < 2; ++c) {
    tq[c] = t0 + 32 * w + 16 * c + q;
#pragma unroll
    for (int ks = 0; ks < 3; ++ks)
      Qf[c][ks] = *(const bf16x8*)(CQF + (((size_t)b * S_ + tq[c]) * 8 + h) * 96 + ks * 32 + g4 * 8);
  }
  const float sc2 = 0.10206207261596575f * LOG2E;
  float m[2] = {-1e28f, -1e28f}, l[2] = {0.f, 0.f};
  f32x4 O[2][4];
#pragma unroll
  for (int c = 0; c < 2; ++c)
#pragma unroll
    for (int dt = 0; dt < 4; ++dt) { const float z_ = lz0(); O[c][dt] = f32x4{z_, z_, z_, z_}; }
  const bf16_t* Kb = CK + (size_t)(b * 8 + h) * S_ * 96;
  const bf16_t* Vb = CVT + (size_t)(b * 8 + h) * 64 * S_;
  const int ntile = 2 * qb + 2;
  const int wmax = t0 + 32 * w + 31, wmin = t0 + 32 * w;
  KVREGS(rg, 96);
  kv_gload(96, true, rg, Kb, Vb, S_);
  for (int j = 0; j < ntile; ++j) {
    __syncthreads();
    kv_sstore(96, true, rg, smem);
    __syncthreads();
    if (j + 1 < ntile) kv_gload(96, true, rg, Kb + (size_t)(j + 1) * 64 * 96, Vb + (j + 1) * 64, S_);
    if (j * 64 <= wmax) {
      const int kmx[2] = {tq[0] - 64 * j, tq[1] - 64 * j}, kmn[2] = {0, 0};
      if (j * 64 + 63 <= wmin) attn_tile<2, 3, 0, 0>(smem, Qf, O, m, l, sc2, kmx, kmn, nullptr, 0);
      else attn_tile<2, 3, 0, 1>(smem, Qf, O, m, l, sc2, kmx, kmn, nullptr, 0);
    }
  }
  attn_finish<2>(O, l);
#pragma unroll
  for (int c = 0; c < 2; ++c)
#pragma unroll
    for (int dt = 0; dt < 4; ++dt) {
      uint2 o;
      o.x = pack2(O[c][dt][0] * l[c], O[c][dt][1] * l[c]);
      o.y = pack2(O[c][dt][2] * l[c], O[c][dt][3] * l[c]);
      *(uint2*)(OC + ((size_t)b * S_ + tq[c]) * 512 + h * 64 + dt * 16 + 4 * g4) = o;
    }
}

#define XB_TMO      128
#define XB_XCNT(j)  (256  + 64 * (j))
#define XB_XSUB(j)  (1280 + 64 * (j))
#define XB_XGEN(j)  (2304 + 64 * (j))
#define XB_TOP      3328
#define XB_TOPGEN   3392
#define XCD_BAR_WORDS 3456
#define XB_SPIN_CAP (1u << 18)
#define LAS __attribute__((address_space(3)))

__device__ __forceinline__ unsigned xb_ld(unsigned* p)              { return __hip_atomic_load(p, __ATOMIC_RELAXED, __HIP_MEMORY_SCOPE_AGENT); }
__device__ __forceinline__ unsigned xb_add(unsigned* p, unsigned v) { return __hip_atomic_fetch_add(p, v, __ATOMIC_RELAXED, __HIP_MEMORY_SCOPE_AGENT); }
__device__ __forceinline__ unsigned xb_xcc_id() { return (unsigned)__builtin_amdgcn_s_getreg((3 << 11) | 20) & 0xFu; }
#define XB_SPIN(cond, bar) do { unsigned _sp = 0; while (cond) { __builtin_amdgcn_s_sleep(1); \
    if ((++_sp & 255u) == 0u) { if (xb_ld(&(bar)[XB_TMO])) break; if (_sp > XB_SPIN_CAP) { atomicAdd(&(bar)[XB_TMO], 1u); break; } } } } while (0)

struct XcdBarrier {
    unsigned* bar; unsigned x;
    volatile LAS unsigned* st;
};

__device__ __forceinline__ XcdBarrier xcd_barrier_post(unsigned* bar, volatile LAS unsigned* st) {
    XcdBarrier b; b.bar = bar; b.x = xb_xcc_id(); b.st = st;
    if (threadIdx.x == 0) (void)xb_add(&bar[XB_XCNT(b.x)], 1u);
    return b;
}
__device__ __forceinline__ void xcd_barrier_complete(unsigned* bar, unsigned x, unsigned& nloc, unsigned& nx) {
    const unsigned G = gridDim.x * gridDim.y * gridDim.z;
    unsigned sum, cnt, mine, sp = 0u;
    for (;;) {
        sum = 0u; cnt = 0u; mine = 0u;
#pragma unroll
        for (unsigned j = 0; j < 16; ++j) { const unsigned c = xb_ld(&bar[XB_XCNT(j)]); sum += c; cnt += (c > 0u) ? 1u : 0u; mine = (j == x) ? c : mine; }
        if (sum == G) break;
        __builtin_amdgcn_s_sleep(1);
        if ((++sp & 255u) == 0u) { if (xb_ld(&bar[XB_TMO])) break; if (sp > XB_SPIN_CAP) { atomicAdd(&bar[XB_TMO], 1u); break; } }
    }
    nloc = mine > 0u ? mine : 1u; nx = cnt > 0u ? cnt : 1u;
}

__device__ __forceinline__ void xcd_barrier(const XcdBarrier& b) {
    asm volatile("s_waitcnt vmcnt(0)" ::: "memory");
    __syncthreads();
    if (threadIdx.x == 0) {
        unsigned* bar = b.bar;
        const unsigned bx_ = xb_xcc_id();
        __builtin_amdgcn_s_waitcnt(0);
        unsigned nloc = b.st[0], nx = b.st[1];
        if (nloc == 0u) { xcd_barrier_complete(bar, bx_, nloc, nx); b.st[0] = nloc; b.st[1] = nx; }
        const unsigned old = xb_add(&bar[XB_XSUB(bx_)], 1u);
        const unsigned gen = old / nloc;
        if (old + 1u == (gen + 1u) * nloc) {
            __builtin_amdgcn_fence(__ATOMIC_RELEASE, "agent");
            asm volatile("s_waitcnt vmcnt(0)" ::: "memory");
            const unsigned og = xb_add(&bar[XB_TOP], 1u);
            const unsigned tg = og / nx;
            if (og + 1u == (tg + 1u) * nx) xb_add(&bar[XB_TOPGEN], 1u);
            else XB_SPIN(xb_ld(&bar[XB_TOPGEN]) == tg, bar);
            __builtin_amdgcn_fence(__ATOMIC_ACQUIRE, "agent");
            xb_add(&bar[XB_XGEN(bx_)], 1u);
            asm volatile("s_waitcnt vmcnt(0)" ::: "memory");
        } else {
            XB_SPIN(xb_ld(&bar[XB_XGEN(bx_)]) == gen, bar);
            __builtin_amdgcn_fence(__ATOMIC_ACQUIRE, "agent");
            asm volatile("s_waitcnt vmcnt(0)" ::: "memory");
        }
    }
    __syncthreads();
}


DI void tile_map(int q, int Nt, bool xcd, int& mt, int& nt) {
  if (!xcd) { mt = q / Nt; nt = q % Nt; return; }
  const int c = q >> 7;
  int ml, nl, mg;
  if (8 * c + 8 <= Nt) {
    const int r = q & 127;
    ml = r & 7; nl = (r >> 3) & 7; mg = r >> 6;
  } else {
    const int wN = Nt - 8 * c, r = q - 128 * c, rest = r >> 3;
    ml = r & 7; nl = rest % wN; mg = rest / wN;
  }
  mt = 16 * (int)(blockIdx.x & 7) + 8 * mg + ml;
  nt = 8 * c + nl;
}
#define TILE_LOOP(Nt) for (int q_ = (xcdmap ? (int)(blockIdx.x >> 3) : vbid); q_ < (xcdmap ? 16 * (Nt) : 128 * (Nt)); q_ += (xcdmap ? 64 : G))

#define DECL_PTRS \
  bf16_t* Wb = (bf16_t*)(ws + OFF_W); \
  bf16_t* H = (bf16_t*)(ws + OFF_H); \
  bf16_t* AQ = (bf16_t*)(ws + OFF_Z); \
  bf16_t* AKC = (bf16_t*)(ws + OFF_Z + 16 * MiB); \
  bf16_t* BQ = (bf16_t*)(ws + OFF_Z + 40 * MiB); \
  bf16_t* BK = (bf16_t*)(ws + OFF_Z + 56 * MiB); \
  bf16_t* BVT = (bf16_t*)(ws + OFF_Z + 60 * MiB); \
  bf16_t* CQ = (bf16_t*)(ws + OFF_Z + 64 * MiB); \
  bf16_t* CKV = (bf16_t*)(ws + OFF_Z + 72 * MiB); \
  float* AG = (float*)(ws + OFF_Z + 80 * MiB); \
  bf16_t* CQF = (bf16_t*)(ws + OFF_M); \
  bf16_t* CK = (bf16_t*)(ws + OFF_M + 24 * MiB); \
  bf16_t* CVT = (bf16_t*)(ws + OFF_M + 48 * MiB); \
  bf16_t* MERGED = (bf16_t*)(ws + OFF_M); \
  bf16_t* ACT = (bf16_t*)(ws + OFF_Z); \
  float* COS64 = (float*)(ws + OFF_X); \
  float* SIN64 = (float*)(ws + OFF_X + 2 * MiB); \
  float* COS32 = (float*)(ws + OFF_X + 4 * MiB); \
  float* SIN32 = (float*)(ws + OFF_X + 5 * MiB); \
  bf16_t* HID = (bf16_t*)(ws + OFF_X + 6 * MiB); \
  bf16_t* KCMP = (bf16_t*)(ws + OFF_X + 8 * MiB); \
  bf16_t* VCMPT = (bf16_t*)(ws + OFF_X + 8 * MiB + 256 * 1024); \
  float* BIAS = (float*)(ws + OFF_X + 8 * MiB + 512 * 1024); \
  bf16_t* PB = (bf16_t*)(ws + OFF_X + 10 * MiB);

__global__ void __launch_bounds__(256, 2) mega(Params P) {
  cg::grid_group grid = cg::this_grid();
  __shared__ __attribute__((aligned(16))) char smem[SMEM_BYTES];
  char* ws0 = P.ws;
  __shared__ uint4 xb_words;
  if (threadIdx.x == 0) xb_words = make_uint4(0u, 0u, 0u, 0u);
  __syncthreads();
  if (P.ws == nullptr) grid.sync();
  const XcdBarrier xb = xcd_barrier_post((unsigned*)(ws0 + OFF_BAR), (volatile LAS unsigned*)&xb_words);
  const int G = gridDim.x;
  const bool xcdmap = (G == 512);
  const int vbid = (G & 7) ? (int)blockIdx.x : (int)((blockIdx.x & 7) * (G >> 3) + (blockIdx.x >> 3));

  float* xo = gptr(P.out);

  {
    char* ws = launder(ws0);
    DECL_PTRS
    const int tid = lv(threadIdx.x);
    const int gtid = blockIdx.x * 256 + tid, gthreads = ls(G) * 256;
    (void)Wb; (void)H;
        const int* posi = (const int*)gptr(P.in[2]);
        for (int i = gtid; i < T_ * 32; i += gthreads) {
          const int t = i >> 5, ff = i & 31;
          float c, sn;
          sincos_acc((float)posi[t] * INVF64[ff], c, sn);
          COS64[i] = c;
          SIN64[i] = sn;
        }
        for (int i = gtid; i < T_ * 16; i += gthreads) {
          const int t = i >> 4, ff = i & 15;
          float c, sn;
          sincos_acc((float)posi[t] * INVF64[2 * ff], c, sn);
          COS32[i] = c;
          SIN32[i] = sn;
        }
      }
  for (int layer = 0; layer < 2; ++layer) {
    const float* xi = layer == 0 ? gptr(P.in[0]) : (const float*)gptr(P.out);
    {
      char* ws = launder(ws0);
      DECL_PTRS
      const int tid = lv(threadIdx.x), lane = tid & 63, w = tid >> 6, wm = w >> 1, wn = w & 1, f = lane & 31, hi = lane >> 5;
      const int gtid = blockIdx.x * 256 + tid, gthreads = ls(G) * 256;
      (void)wm; (void)wn; (void)f; (void)hi; (void)gtid; (void)gthreads; (void)w;
    {
      int base = 0;
      const float* w_in = gptr(P.in[4]) + (size_t)layer * 1024 * 2616;
      conv_seg(w_in, 2616, 0, 1280, 1024, Wb + W_IN, 0, base, smem);
      conv_seg(w_in, 2616, 1304, 1312, 1024, Wb + W_IN, 1280, base, smem);
      conv_seg(w_in, 2616, 1280, 24, 1024, Wb + W_IN, 2592, base, smem);
      conv_seg(gptr(P.in[6]) + (size_t)layer * 2048 * 256, 256, 0, 256, 2048, Wb + W_1K, 0, base, smem);
      conv_seg(gptr(P.in[9]) + (size_t)layer * 2048 * 256, 256, 0, 256, 2048, Wb + W_1V, 0, base, smem);
      conv_seg(gptr(P.in[7]) + (size_t)layer * 256 * 64, 64, 0, 64, 256, Wb + W_2K, 0, base, smem);
      conv_seg(gptr(P.in[10]) + (size_t)layer * 256 * 64, 64, 0, 64, 256, Wb + W_2V, 0, base, smem);
      {
        const float* wq = gptr(P.in[13]) + (size_t)layer * 256 * 768;
        const float* wkv = gptr(P.in[15]) + (size_t)layer * 256 * 1024;
        for (int h = 0; h < 8; ++h) {
          conv_seg(wq, 768, h * 96, 64, 256, Wb + W_QUP, h * 64, base, smem);
          conv_seg(wq, 768, h * 96 + 64, 32, 256, Wb + W_QUP, 512 + h * 32, base, smem);
          conv_seg(wkv, 1024, h * 128, 64, 256, Wb + W_KVUP, h * 64, base, smem);
          conv_seg(wkv, 1024, h * 128 + 64, 64, 256, Wb + W_KVUP, 512 + h * 64, base, smem);
        }
      }
      conv_seg(gptr(P.in[16]) + (size_t)layer * 1024 * 3072, 3072, 0, 3072, 1024, Wb + W_G, 0, base, smem);
      conv_seg(gptr(P.in[17]) + (size_t)layer * 512 * 1024, 1024, 0, 1024, 512, Wb + W_PA, 0, base, smem);
      conv_seg(gptr(P.in[18]) + (size_t)layer * 512 * 1024, 1024, 0, 1024, 512, Wb + W_PB, 0, base, smem);
      conv_seg(gptr(P.in[19]) + (size_t)layer * 512 * 1024, 1024, 0, 1024, 512, Wb + W_PC, 0, base, smem);
      conv_seg(gptr(P.in[20]) + (size_t)layer * 1024 * 1024, 1024, 0, 1024, 1024, Wb + W_OUT, 0, base, smem);
      {
        const float* wg = gptr(P.in[22]) + (size_t)layer * 1024 * DFF;
        const float* wu = gptr(P.in[23]) + (size_t)layer * 1024 * DFF;
        conv_seg<true>(wg, DFF, 0, DFF, 1024, Wb + W_GU, 0, base, smem);
        conv_seg<true>(wu, DFF, 0, DFF, 1024, Wb + W_GU, 32, base, smem);
      }
      conv_seg(gptr(P.in[24]) + (size_t)layer * DFF * 1024, 1024, 0, 1024, DFF, Wb + W_DOWN, 0, base, smem);
      conv_seg(gptr(P.in[26]) + (size_t)layer * 256 * 1024, 1024, 0, 1024, 256, Wb + W_PLEP, 0, base, smem);
      conv_seg(gptr(P.in[27]) + (size_t)layer * 1024 * 1024, 1024, 0, 1024, 1024, Wb + W_PLEG, 0, base, smem);
      const unsigned zu_ = (unsigned)lv(0);
      for (int i = gtid; i < 72 * 1024 / 8; i += gthreads) ((uint4*)(Wb + W_IN + 2616ull * 1024))[i] = make_uint4(zu_, zu_, zu_, zu_);
      for (int i = gtid; i < 2 * 64 * 256 / 8; i += gthreads) {
        const int which = i / (64 * 256 / 8), r = i % (64 * 256 / 8);
        ((uint4*)(Wb + (which ? W_2V : W_2K) + 64ull * 256))[r] = make_uint4(zu_, zu_, zu_, zu_);
      }
      __syncthreads();
      if (blockIdx.x < 16) {
        const int which = blockIdx.x >> 3, part = blockIdx.x & 7;
        const float* pos = gptr(P.in[which ? 8 : 5]) + (size_t)layer * 2048;
        const float* w1 = gptr(P.in[which ? 9 : 6]) + (size_t)layer * 2048 * 256;
        const int c = tid & 31, ks = tid >> 5;
        float sacc = 0.f;
        for (int k = ks * 256; k < ks * 256 + 256; ++k) sacc += pos[k] * w1[(size_t)k * 256 + part * 32 + c];
        float* red = (float*)smem;
        red[tid] = sacc;
        __syncthreads();
        if (tid < 32) {
          float t = 0.f;
          for (int i = 0; i < 8; ++i) t += red[i * 32 + tid];
          BIAS[which * 256 + part * 32 + tid] = t;
        }
      }
      {
        const float* pp = gptr(P.in[1]) + (size_t)layer * T_ * 256;
        for (int i = gtid; i < T_ * 256 / 4; i += gthreads) {
          const float4 v = ((const float4*)pp)[i];
          uint2 o;
          o.x = pack2(v.x, v.y);
          o.y = pack2(v.z, v.w);
          ((uint2*)PB)[i] = o;
        }
      }
      norm_rows_f32(xi, gptr(P.in[3]) + layer * DM, H);
    }
    }
    xcd_barrier(xb);
    {
      char* ws = launder(ws0);
      DECL_PTRS
      const int tid = lv(threadIdx.x), lane = tid & 63, w = tid >> 6, wm = w >> 1, wn = w & 1, f = lane & 31, hi = lane >> 5;
      const int gtid = blockIdx.x * 256 + tid, gthreads = ls(G) * 256;
      (void)wm; (void)wn; (void)f; (void)hi; (void)gtid; (void)gthreads; (void)w;
    TILE_LOOP(20) {
      int mt, nt;
      tile_map(q_, 20, xcdmap, mt, nt);
      const int m0 = mt * 128;
      f32x16 acc[2][2];
      zero_acc<2>(acc);
      mma_block<2>(H + (size_t)m0 * DM, DM, Wb + W_IN + (size_t)nt * 128 * 1024, 1024, 1024, acc, smem);
      const int seg = nt * 2 + wn;
      int kind, hh = 0;
      bf16_t* dst = nullptr;
      if (seg < 8) { kind = 0; dst = AQ; hh = seg; }
      else if (seg < 20) {
        const int a = (seg - 8) >> 1;
        hh = (seg - 8) & 1;
        dst = AKC + (size_t)a * (2 * MiB);
        kind = (a == 0 || a == 2 || a == 4) ? 1 : (a == 1 ? 2 : 3);
      }
      else if (seg < 28) { kind = 0; dst = BQ; hh = seg - 20; }
      else if (seg < 30) { kind = 1; dst = BK; hh = seg - 28; }
      else if (seg < 32) { kind = 3; dst = BVT; hh = seg - 30; }
      else if (seg < 36) { kind = 4; dst = CQ + (seg - 32) * 64; }
      else if (seg < 40) { kind = 4; dst = CKV + (seg - 36) * 64; }
      else if (seg == 40) kind = 5;
      else kind = 6;
#pragma unroll
      for (int mi = 0; mi < 2; ++mi) {
#pragma unroll
        for (int i4 = 0; i4 < 4; ++i4) {
          const int tb = m0 + wm * 64 + mi * 32 + 8 * i4 + 4 * hi;
          const int b = tb >> 13, s0 = tb & 8191;
          if (kind == 3) {
            uint2 o0, o1;
            o0.x = pack2(acc[mi][0][4 * i4], acc[mi][0][4 * i4 + 1]);
            o0.y = pack2(acc[mi][0][4 * i4 + 2], acc[mi][0][4 * i4 + 3]);
            o1.x = pack2(acc[mi][1][4 * i4], acc[mi][1][4 * i4 + 1]);
            o1.y = pack2(acc[mi][1][4 * i4 + 2], acc[mi][1][4 * i4 + 3]);
            *(uint2*)(dst + ((size_t)(b * 2 + hh) * 64 + f) * S_ + s0) = o0;
            *(uint2*)(dst + ((size_t)(b * 2 + hh) * 64 + f + 32) * S_ + s0) = o1;
          } else if (kind != 6) {
#pragma unroll
            for (int e = 0; e < 4; ++e) {
              const int t = tb + e, s = s0 + e;
              const float v0 = acc[mi][0][4 * i4 + e], v1 = acc[mi][1][4 * i4 + e];
              if (kind <= 1) {
                const float c = COS64[t * 32 + f], sn = SIN64[t * 32 + f];
                const float r0 = v0 * c - v1 * sn, r1 = v1 * c + v0 * sn;
                const size_t idx = kind == 0 ? ((size_t)t * 8 + hh) * 64 + f : ((size_t)(b * 2 + hh) * S_ + s) * 64 + f;
                dst[idx] = f2bf(r0);
                dst[idx + 32] = f2bf(r1);
              } else if (kind == 2) {
                const size_t idx = ((size_t)(b * 2 + hh) * S_ + s) * 64 + f;
                dst[idx] = f2bf(v0);
                dst[idx + 32] = f2bf(v1);
              } else if (kind == 4) {
                dst[(size_t)t * 256 + f] = f2bf(v0);
                dst[(size_t)t * 256 + f + 32] = f2bf(v1);
              } else {
                const float c = COS32[t * 16 + (f & 15)], sn = SIN32[t * 16 + (f & 15)];
                const float pr = __shfl_xor(v0, 16);
                const float r = (f < 16) ? v0 * c - pr * sn : v0 * c + pr * sn;
                const bf16_t rb = f2bf(r);
#pragma unroll
                for (int h = 0; h < 8; ++h) CK[((size_t)(b * 8 + h) * S_ + s) * 96 + 64 + f] = rb;
                if (f < 24) AG[(size_t)t * 24 + f] = sigmoidf_(v1);
              }
            }
          }
        }
      }
    }
    }
    xcd_barrier(xb);
    {
      char* ws = launder(ws0);
      DECL_PTRS
      const int tid = lv(threadIdx.x), lane = tid & 63, w = tid >> 6, wm = w >> 1, wn = w & 1, f = lane & 31, hi = lane >> 5;
      const int gtid = blockIdx.x * 256 + tid, gthreads = ls(G) * 256;
      (void)wm; (void)wn; (void)f; (void)hi; (void)gtid; (void)gthreads; (void)w;
    for (int tix = vbid - 64; tix < 128; tix += G) {
      if (tix < 0) continue;
      const int m0 = tix * 128;
      f32x16 acc[2][1];
      zero_acc<1>(acc);
      mma_block<1>(H + (size_t)m0 * DM, DM, Wb + W_IN + (size_t)2560 * 1024, 1024, 1024, acc, smem);
#pragma unroll
      for (int mi = 0; mi < 2; ++mi)
#pragma unroll
        for (int i = 0; i < 16; ++i) {
          const int t = m0 + wm * 64 + mi * 32 + (i & 3) + 8 * (i >> 2) + 4 * hi;
          const int b = t >> 13, sx = t & 8191;
          const float v0 = acc[mi][0][i];
          if (wn == 0) {
            const float c = COS32[t * 16 + (f & 15)], sn = SIN32[t * 16 + (f & 15)];
            const float pr = __shfl_xor(v0, 16);
            const float r = (f < 16) ? v0 * c - pr * sn : v0 * c + pr * sn;
            const bf16_t rb = f2bf(r);
#pragma unroll
            for (int h = 0; h < 8; ++h) CK[((size_t)(b * 8 + h) * S_ + sx) * 96 + 64 + f] = rb;
          } else if (f < 24) {
            AG[(size_t)t * 24 + f] = sigmoidf_(v0);
          }
        }
    }
    for (int tix = vbid; tix < 64; tix += G) {
      const int which = tix >> 5, mt = (tix >> 1) & 15, nt = tix & 1;
      f32x16 acc[2][2];
      zero_acc<2>(acc);
      mma_block<2>(AKC + (size_t)which * (2 * MiB) + (size_t)mt * 128 * 1024, 1024,
                   Wb + (which ? W_1V : W_1K) + (size_t)nt * 128 * 2048, 2048, 2048, acc, smem);
#pragma unroll
      for (int mi = 0; mi < 2; ++mi)
#pragma unroll
        for (int ni = 0; ni < 2; ++ni)
#pragma unroll
          for (int i = 0; i < 16; ++i) {
            const int row = mt * 128 + wm * 64 + mi * 32 + (i & 3) + 8 * (i >> 2) + 4 * hi;
            const int col = nt * 128 + wn * 64 + ni * 32 + f;
            const float x = acc[mi][ni][i] + BIAS[which * 256 + col];
            const float y = 0.5f * x * (1.f + tanhf(0.7978845608028654f * (x + 0.044715f * x * x * x)));
            HID[(size_t)which * 2048 * 256 + (size_t)row * 256 + col] = f2bf(y);
          }
    }
    for (int r = blockIdx.x * 4 + w; r < 2 * T_; r += G * 4) {
      const int which = r >= T_;
      const int row = which ? r - T_ : r;
      bf16_t* p = (which ? CKV : CQ) + (size_t)row * 256 + lane * 4;
      const float* gain = gptr(P.in[which ? 14 : 12]) + layer * 256 + lane * 4;
      const uint2 v = *(const uint2*)p;
      const float a0 = bflo(v.x), a1 = bfhi(v.x), a2 = bflo(v.y), a3 = bfhi(v.y);
      const float ss = wave_sum(a0 * a0 + a1 * a1 + a2 * a2 + a3 * a3);
      const float rs = rsqrtf(ss * (1.f / 256.f) + 1e-6f);
      uint2 o;
      o.x = pack2(a0 * rs * gain[0], a1 * rs * gain[1]);
      o.y = pack2(a2 * rs * gain[2], a3 * rs * gain[3]);
      *(uint2*)p = o;
    }
    }
    xcd_barrier(xb);
    {
      char* ws = launder(ws0);
      DECL_PTRS
      const int tid = lv(threadIdx.x), lane = tid & 63, w = tid >> 6, wm = w >> 1, wn = w & 1, f = lane & 31, hi = lane >> 5;
      const int gtid = blockIdx.x * 256 + tid, gthreads = ls(G) * 256;
      (void)wm; (void)wn; (void)f; (void)hi; (void)gtid; (void)gthreads; (void)w;
    for (int tix = vbid; tix < 768 + 1024 + 32; tix += G) {
      f32x16 acc[2][2];
      zero_acc<2>(acc);
      if (tix < 768) {
        const int mt = tix / 6, nt = tix % 6, m0 = mt * 128;
        mma_block<2>(CQ + (size_t)m0 * 256, 256, Wb + W_QUP + (size_t)nt * 128 * 256, 256, 256, acc, smem);
        const int seg = nt * 2 + wn;
#pragma unroll
        for (int mi = 0; mi < 2; ++mi)
#pragma unroll
          for (int i = 0; i < 16; ++i) {
            const int t = m0 + wm * 64 + mi * 32 + (i & 3) + 8 * (i >> 2) + 4 * hi;
            if (seg < 8) {
              bf16_t* d = CQF + ((size_t)t * 8 + seg) * 96 + f;
              d[0] = f2bf(acc[mi][0][i]);
              d[32] = f2bf(acc[mi][1][i]);
            } else {
              const float c = COS32[t * 16 + (f & 15)], sn = SIN32[t * 16 + (f & 15)];
#pragma unroll
              for (int ni = 0; ni < 2; ++ni) {
                const float v0 = acc[mi][ni][i];
                const float pr = __shfl_xor(v0, 16);
                const float r = (f < 16) ? v0 * c - pr * sn : v0 * c + pr * sn;
                CQF[((size_t)t * 8 + (seg - 8) * 2 + ni) * 96 + 64 + f] = f2bf(r);
              }
            }
          }
      } else if (tix < 768 + 1024) {
        const int u = tix - 768, mt = u >> 3, nt = u & 7, m0 = mt * 128;
        mma_block<2>(CKV + (size_t)m0 * 256, 256, Wb + W_KVUP + (size_t)nt * 128 * 256, 256, 256, acc, smem);
        const int seg = nt * 2 + wn;
#pragma unroll
        for (int mi = 0; mi < 2; ++mi)
#pragma unroll
          for (int i4 = 0; i4 < 4; ++i4) {
            const int tb = m0 + wm * 64 + mi * 32 + 8 * i4 + 4 * hi;
            const int b = tb >> 13, s0 = tb & 8191;
            if (seg < 8) {
#pragma unroll
              for (int e = 0; e < 4; ++e) {
                bf16_t* d = CK + ((size_t)(b * 8 + seg) * S_ + s0 + e) * 96 + f;
                d[0] = f2bf(acc[mi][0][4 * i4 + e]);
                d[32] = f2bf(acc[mi][1][4 * i4 + e]);
              }
            } else {
              uint2 o0, o1;
              o0.x = pack2(acc[mi][0][4 * i4], acc[mi][0][4 * i4 + 1]);
              o0.y = pack2(acc[mi][0][4 * i4 + 2], acc[mi][0][4 * i4 + 3]);
              o1.x = pack2(acc[mi][1][4 * i4], acc[mi][1][4 * i4 + 1]);
              o1.y = pack2(acc[mi][1][4 * i4 + 2], acc[mi][1][4 * i4 + 3]);
              *(uint2*)(CVT + ((size_t)(b * 8 + seg - 8) * 64 + f) * S_ + s0) = o0;
              *(uint2*)(CVT + ((size_t)(b * 8 + seg - 8) * 64 + f + 32) * S_ + s0) = o1;
            }
          }
      } else {
        const int u = tix - 1792, which = u >> 4, mt = u & 15;
        mma_block<2>(HID + (size_t)which * 2048 * 256 + (size_t)mt * 128 * 256, 256, Wb + (which ? W_2V : W_2K), 256, 256,
                     acc, smem);
        if (wn == 0) {
#pragma unroll
          for (int mi = 0; mi < 2; ++mi)
#pragma unroll
            for (int i4 = 0; i4 < 4; ++i4) {
              const int rb = mt * 128 + wm * 64 + mi * 32 + 8 * i4 + 4 * hi;
              if (which == 0) {
#pragma unroll
                for (int e = 0; e < 4; ++e) {
                  KCMP[(size_t)(rb + e) * 64 + f] = f2bf(acc[mi][0][4 * i4 + e]);
                  KCMP[(size_t)(rb + e) * 64 + f + 32] = f2bf(acc[mi][1][4 * i4 + e]);
                }
              } else {
                const int bg = rb >> 9, n0 = rb & 511;
                uint2 o0, o1;
                o0.x = pack2(acc[mi][0][4 * i4], acc[mi][0][4 * i4 + 1]);
                o0.y = pack2(acc[mi][0][4 * i4 + 2], acc[mi][0][4 * i4 + 3]);
                o1.x = pack2(acc[mi][1][4 * i4], acc[mi][1][4 * i4 + 1]);
                o1.y = pack2(acc[mi][1][4 * i4 + 2], acc[mi][1][4 * i4 + 3]);
                *(uint2*)(VCMPT + ((size_t)bg * 64 + f) * 512 + n0) = o0;
                *(uint2*)(VCMPT + ((size_t)bg * 64 + f + 32) * 512 + n0) = o1;
              }
            }
        }
      }
    }
    }
    xcd_barrier(xb);
    {
      char* ws = launder(ws0);
      DECL_PTRS
      const int tid = lv(threadIdx.x), lane = tid & 63, w = tid >> 6, wm = w >> 1, wn = w & 1, f = lane & 31, hi = lane >> 5;
      const int gtid = blockIdx.x * 256 + tid, gthreads = ls(G) * 256;
      (void)wm; (void)wn; (void)f; (void)hi; (void)gtid; (void)gthreads; (void)w;
    for (int it = blockIdx.x; it < 3072; it += G) {
      if (it < 1024) {
        const int bh = it & 15;
        const int qb = it < 512 ? 63 - (it >> 4) : ((it - 512) >> 4);
        mla_item(P, ws, bh >> 3, bh & 7, qb, smem);
      } else if (it < 2048) {
        const int u = it - 1024, bg = u & 3;
        const int ch = u < 512 ? 255 - (u >> 2) : ((u - 512) >> 2);
        nsa_item(P, ws, bg >> 1, bg & 1, ch, smem);
      } else {
        const int u = it - 2048, bg = u & 3;
        swa_item(P, ws, layer, bg >> 1, bg & 1, u >> 2, smem);
      }
    }
    }
    xcd_barrier(xb);
    {
      char* ws = launder(ws0);
      DECL_PTRS
      const int tid = lv(threadIdx.x), lane = tid & 63, w = tid >> 6, wm = w >> 1, wn = w & 1, f = lane & 31, hi = lane >> 5;
      const int gtid = blockIdx.x * 256 + tid, gthreads = ls(G) * 256;
      (void)wm; (void)wn; (void)f; (void)hi; (void)gtid; (void)gthreads; (void)w;
    TILE_LOOP(8) {
      int mt, nt;
      tile_map(q_, 8, xcdmap, mt, nt);
      const int m0 = mt * 128, n0 = nt * 128;
      uint32_t mpk[2][2][8];
#pragma unroll
      for (int mi = 0; mi < 2; ++mi)
#pragma unroll
        for (int ni = 0; ni < 2; ++ni)
#pragma unroll
          for (int i = 0; i < 8; ++i) mpk[mi][ni][i] = 0u;
#pragma unroll 1
      for (int br = 0; br < 3; ++br) {
        const bf16_t* Ob = br == 0 ? AQ : (br == 1 ? BQ : CQ);
        f32x16 acc[2][2];
        zero_acc<2>(acc);
        mma_block<2, true>(Ob + (size_t)m0 * 512, 512, Wb + W_PA + (size_t)br * 1024 * 512 + (size_t)n0 * 512, 512, 512, acc, smem);
        uint32_t pk[2][2][8];
#pragma unroll
        for (int mi = 0; mi < 2; ++mi)
#pragma unroll
          for (int ni = 0; ni < 2; ++ni)
#pragma unroll
            for (int i = 0; i < 8; ++i) pk[mi][ni][i] = pack2(acc[mi][ni][2 * i], acc[mi][ni][2 * i + 1]);
        zero_acc<2>(acc);
        mma_block<2, true>(H + (size_t)m0 * DM, DM, Wb + W_G + ((size_t)br * 1024 + n0) * 1024, 1024, 1024, acc, smem);
#pragma unroll
        for (int mi = 0; mi < 2; ++mi)
#pragma unroll
          for (int ni = 0; ni < 2; ++ni)
#pragma unroll
            for (int i = 0; i < 8; ++i) {
              const float a0 = bflo(mpk[mi][ni][i]) + sigmoidf_(acc[mi][ni][2 * i]) * bflo(pk[mi][ni][i]);
              const float a1 = bfhi(mpk[mi][ni][i]) + sigmoidf_(acc[mi][ni][2 * i + 1]) * bfhi(pk[mi][ni][i]);
              mpk[mi][ni][i] = pack2(a0, a1);
            }
      }
#pragma unroll
      for (int mi = 0; mi < 2; ++mi)
#pragma unroll
        for (int ni = 0; ni < 2; ++ni)
#pragma unroll
          for (int i = 0; i < 8; ++i) {
            const int t = m0 + wm * 64 + mi * 32 + ((2 * i) & 3) + 8 * ((2 * i) >> 2) + 4 * hi;
            bf16_t* mp = MERGED + (size_t)t * DM + n0 + wn * 64 + ni * 32 + f;
            mp[0] = (bf16_t)(mpk[mi][ni][i] & 0xffffu);
            mp[DM] = (bf16_t)(mpk[mi][ni][i] >> 16);
          }
    }
    }
    xcd_barrier(xb);
    {
      char* ws = launder(ws0);
      DECL_PTRS
      const int tid = lv(threadIdx.x), lane = tid & 63, w = tid >> 6, wm = w >> 1, wn = w & 1, f = lane & 31, hi = lane >> 5;
      const int gtid = blockIdx.x * 256 + tid, gthreads = ls(G) * 256;
      (void)wm; (void)wn; (void)f; (void)hi; (void)gtid; (void)gthreads; (void)w;
    TILE_LOOP(8) {
      int mt, nt;
      tile_map(q_, 8, xcdmap, mt, nt);
      const int m0 = mt * 128, n0 = nt * 128;
      f32x16 acc[2][2];
      zero_acc<2>(acc);
      mma_block<2>(MERGED + (size_t)m0 * DM, DM, Wb + W_OUT + (size_t)n0 * 1024, 1024, 1024, acc, smem);
#pragma unroll
      for (int mi = 0; mi < 2; ++mi)
#pragma unroll
        for (int ni = 0; ni < 2; ++ni)
#pragma unroll
          for (int i = 0; i < 16; ++i) {
            const size_t idx = (size_t)(m0 + wm * 64 + mi * 32 + (i & 3) + 8 * (i >> 2) + 4 * hi) * DM + n0 + wn * 64 + ni * 32 + f;
            xo[idx] = xi[idx] + acc[mi][ni][i];
            if ((i & 15) == 15) asm volatile("" ::: "memory");
          }
    }
    }
    xcd_barrier(xb);
    {
      char* ws = launder(ws0);
      DECL_PTRS
      const int tid = lv(threadIdx.x), lane = tid & 63, w = tid >> 6, wm = w >> 1, wn = w & 1, f = lane & 31, hi = lane >> 5;
      const int gtid = blockIdx.x * 256 + tid, gthreads = ls(G) * 256;
      (void)wm; (void)wn; (void)f; (void)hi; (void)gtid; (void)gthreads; (void)w;
    norm_rows_f32(xo, gptr(P.in[21]) + layer * DM, H);
    }
    xcd_barrier(xb);
    {
      char* ws = launder(ws0);
      DECL_PTRS
      const int tid = lv(threadIdx.x), lane = tid & 63, w = tid >> 6, wm = w >> 1, wn = w & 1, f = lane & 31, hi = lane >> 5;
      const int gtid = blockIdx.x * 256 + tid, gthreads = ls(G) * 256;
      (void)wm; (void)wn; (void)f; (void)hi; (void)gtid; (void)gthreads; (void)w;
    TILE_LOOP(44) {
      int mt, nt;
      tile_map(q_, 44, xcdmap, mt, nt);
      const int m0 = mt * 128;
      f32x16 acc[2][2];
      zero_acc<2>(acc);
      mma_block<2>(H + (size_t)m0 * DM, DM, Wb + W_GU + (size_t)nt * 128 * 1024, 1024, 1024, acc, smem);
      const int cb = (nt * 2 + wn) * 32 + f;
#pragma unroll
      for (int mi = 0; mi < 2; ++mi)
#pragma unroll
        for (int i = 0; i < 16; ++i) {
          const int t = m0 + wm * 64 + mi * 32 + (i & 3) + 8 * (i >> 2) + 4 * hi;
          const float gte = acc[mi][0][i], up = acc[mi][1][i];
          ACT[(size_t)t * DFF + cb] = f2bf(gte * sigmoidf_(gte) * up);
        }
    }
    }
    xcd_barrier(xb);
    {
      char* ws = launder(ws0);
      DECL_PTRS
      const int tid = lv(threadIdx.x), lane = tid & 63, w = tid >> 6, wm = w >> 1, wn = w & 1, f = lane & 31, hi = lane >> 5;
      const int gtid = blockIdx.x * 256 + tid, gthreads = ls(G) * 256;
      (void)wm; (void)wn; (void)f; (void)hi; (void)gtid; (void)gthreads; (void)w;
    TILE_LOOP(8) {
      int mt, nt;
      tile_map(q_, 8, xcdmap, mt, nt);
      const int m0 = mt * 128, n0 = nt * 128;
      f32x16 acc[2][2];
      zero_acc<2>(acc);
      mma_block<2>(ACT + (size_t)m0 * DFF, DFF, Wb + W_DOWN + (size_t)n0 * DFF, DFF, DFF, acc, smem);
#pragma unroll
      for (int mi = 0; mi < 2; ++mi)
#pragma unroll
        for (int ni = 0; ni < 2; ++ni)
#pragma unroll
          for (int i = 0; i < 16; ++i) {
            const size_t idx = (size_t)(m0 + wm * 64 + mi * 32 + (i & 3) + 8 * (i >> 2) + 4 * hi) * DM + n0 + wn * 64 + ni * 32 + f;
            xo[idx] += acc[mi][ni][i];
            if ((i & 15) == 15) asm volatile("" ::: "memory");
          }
    }
    }
    xcd_barrier(xb);
    {
      char* ws = launder(ws0);
      DECL_PTRS
      const int tid = lv(threadIdx.x), lane = tid & 63, w = tid >> 6, wm = w >> 1, wn = w & 1, f = lane & 31, hi = lane >> 5;
      const int gtid = blockIdx.x * 256 + tid, gthreads = ls(G) * 256;
      (void)wm; (void)wn; (void)f; (void)hi; (void)gtid; (void)gthreads; (void)w;
    norm_rows_f32(xo, gptr(P.in[25]) + layer * DM, H);
    }
    xcd_barrier(xb);
    {
      char* ws = launder(ws0);
      DECL_PTRS
      const int tid = lv(threadIdx.x), lane = tid & 63, w = tid >> 6, wm = w >> 1, wn = w & 1, f = lane & 31, hi = lane >> 5;
      const int gtid = blockIdx.x * 256 + tid, gthreads = ls(G) * 256;
      (void)wm; (void)wn; (void)f; (void)hi; (void)gtid; (void)gthreads; (void)w;
    TILE_LOOP(16) {
      int mt, nt;
      tile_map(q_, 16, xcdmap, mt, nt);
      const int m0 = mt * 128, n0 = nt * 64;
      f32x16 acc[2][1];
      zero_acc<1>(acc);
      mma_block<1>(PB + (size_t)m0 * 256, 256, Wb + W_PLEP + (size_t)n0 * 256, 256, 256, acc, smem);
      uint32_t pk[2][8];
#pragma unroll
      for (int mi = 0; mi < 2; ++mi)
#pragma unroll
        for (int i = 0; i < 8; ++i) pk[mi][i] = pack2(acc[mi][0][2 * i], acc[mi][0][2 * i + 1]);
      zero_acc<1>(acc);
      mma_block<1>(H + (size_t)m0 * DM, DM, Wb + W_PLEG + (size_t)n0 * 1024, 1024, 1024, acc, smem);
#pragma unroll
      for (int mi = 0; mi < 2; ++mi)
#pragma unroll
        for (int i = 0; i < 16; ++i) {
          const size_t idx = (size_t)(m0 + wm * 64 + mi * 32 + (i & 3) + 8 * (i >> 2) + 4 * hi) * DM + n0 + wn * 32 + f;
          const uint32_t pv = pk[mi][i >> 1];
          const float pj = (i & 1) ? bfhi(pv) : bflo(pv);
          xo[idx] += sigmoidf_(acc[mi][0][i]) * pj;
          if ((i & 15) == 15) asm volatile("" ::: "memory");
        }
    }
    }
    xcd_barrier(xb);
  }
  {
    const float* gain = gptr(P.in[28]);
    const int tid = lv(threadIdx.x), lane = tid & 63, w = tid >> 6;
    for (int row = blockIdx.x * 4 + w; row < T_; row += G * 4) {
      float* xp = xo + (size_t)row * DM;
      float4 v[4];
      float ss = 0.f;
#pragma unroll
      for (int i = 0; i < 4; ++i) {
        v[i] = *(const float4*)(xp + i * 256 + lane * 4);
        ss += v[i].x * v[i].x + v[i].y * v[i].y + v[i].z * v[i].z + v[i].w * v[i].w;
      }
      ss = wave_sum(ss);
      const float rs = rsqrtf(ss * (1.f / DM) + 1e-6f);
#pragma unroll
      for (int i = 0; i < 4; ++i) {
        const float4 g = *(const float4*)(gain + i * 256 + lane * 4);
        float4 o;
        o.x = v[i].x * rs * g.x; o.y = v[i].y * rs * g.y; o.z = v[i].z * rs * g.z; o.w = v[i].w * rs * g.w;
        *(float4*)(xp + i * 256 + lane * 4) = o;
      }
    }
  }
}

extern "C" void kernel_launch(void* const* d_in, const int* in_sizes, int n_in, void* d_out, int out_size, void* d_ws,
                              size_t ws_size, hipStream_t stream) {
  static int grid_blocks = 0;
  if (!grid_blocks) {
    int dev = 0, cus = 0, per_cu = 0;
    hipGetDevice(&dev);
    hipDeviceGetAttribute(&cus, hipDeviceAttributeMultiprocessorCount, dev);
    hipOccupancyMaxActiveBlocksPerMultiprocessor(&per_cu, mega, 256, 0);
    if (per_cu > 2) per_cu = 2;
    if (per_cu < 1) per_cu = 1;
    grid_blocks = cus * per_cu;
  }
  if (ws_size < WS_NEED) {
    fprintf(stderr, "workspace too small: %zu < %zu\n", ws_size, (size_t)WS_NEED);
    return;
  }
  hipMemsetAsync((char*)d_ws + OFF_BAR, 0, XCD_BAR_WORDS * sizeof(unsigned), stream);
  Params p{};
  for (int i = 0; i < 29; ++i) p.in[i] = (const float*)d_in[i];
  p.out = (float*)d_out;
  p.ws = (char*)d_ws;
  void* args[] = {&p};
  hipError_t e = hipLaunchCooperativeKernel((void*)mega, dim3(grid_blocks), dim3(256), args, 0, stream);
  if (e != hipSuccess) fprintf(stderr, "cooperative launch failed: %s (grid %d)\n", hipGetErrorString(e), grid_blocks);
}
```
